# Optimizing an MI355X kernel written in HIP

```python
import math
import jax, jax.numpy as jnp
from jax import lax
import numpy as np

D_MODEL = 1024
BATCH = 16
SEQ = 256
DEPTH = 4
DEC_BATCH = 8
DEC_SEQ = 4096
PAST_LEN = 512

GRID_W = 64
Q_BLOCK = 128
ROPE_THETA = 10000.0
EPS = 1e-6
GQA_HEADS = 6
GQA_KV_HEADS = 2
GQA_REP = GQA_HEADS // GQA_KV_HEADS
GQA_HEAD_DIM = 64
MLA_HEADS = 6
MLA_Q_RANK = 256
MLA_KV_RANK = 128
MLA_NOPE_DIM = 64
MLA_ROPE_DIM = 32
MLA_QK_DIM = MLA_NOPE_DIM + MLA_ROPE_DIM
MLA_V_DIM = 64
SSM_GROUPS = 16
SSM_GROUP_CH = 16
SSM_STATE = 64
SSM_CH = SSM_GROUPS * SSM_GROUP_CH
GQA_OUT = GQA_HEADS * GQA_HEAD_DIM
MLA_OUT = MLA_HEADS * MLA_V_DIM
MIX_WIDTH = GQA_OUT + MLA_OUT + SSM_CH
IN_SPLITS = (GQA_HEADS * GQA_HEAD_DIM, GQA_KV_HEADS * GQA_HEAD_DIM, GQA_KV_HEADS * GQA_HEAD_DIM,
             MLA_Q_RANK, MLA_KV_RANK, MLA_ROPE_DIM, SSM_CH)
IN_WIDTH = sum(IN_SPLITS)
IN_OFFSETS = tuple(int(o) for o in np.cumsum(IN_SPLITS)[:-1])
D_FF = -(-8 * D_MODEL // (3 * 256)) * 256

kernel_name = 'hymba_dit_gqa_mla_s5_step'


def rms_norm(x, g):
    xf = x.astype(jnp.float32)
    y = xf * lax.rsqrt(jnp.mean(xf * xf, axis=-1, keepdims=True) + EPS)
    return (y * g.astype(jnp.float32)).astype(x.dtype)


def adaln(cond, w, b):
    mod = jax.nn.silu(cond) @ w + b
    return jnp.split(mod[..., None, :], 6, axis=-1)


def axial_rope(n_tokens, rot_dim):
    rows = n_tokens // GRID_W
    row = jnp.repeat(jnp.arange(rows, dtype=jnp.float32), GRID_W)
    col = jnp.tile(jnp.arange(GRID_W, dtype=jnp.float32), rows)
    quarter = rot_dim // 4
    inv = ROPE_THETA ** (-jnp.arange(quarter, dtype=jnp.float32) / quarter)
    ang = jnp.concatenate([row[:, None] * inv, col[:, None] * inv], axis=-1)
    return jnp.cos(ang)[:, None, :], jnp.sin(ang)[:, None, :]


def apply_rope(x, cos, sin):
    x1, x2 = jnp.split(x.astype(jnp.float32), 2, axis=-1)
    return jnp.concatenate([x1 * cos - x2 * sin, x1 * sin + x2 * cos], axis=-1).astype(x.dtype)


def block_attention(q, k, v, scale):
    B_, L, G, R, Dk = q.shape
    nb = L // Q_BLOCK
    qb = q.reshape(B_, nb, Q_BLOCK, G, R, Dk).transpose(1, 0, 2, 3, 4, 5)

    def one_block(qi):
        s = jnp.einsum('bqgrd,bkgd->bgrqk', qi, k).astype(jnp.float32) * scale
        p = jax.nn.softmax(s, axis=-1).astype(v.dtype)
        return jnp.einsum('bgrqk,bkge->bqgre', p, v)

    o = lax.map(one_block, qb)
    return o.transpose(1, 0, 2, 3, 4, 5).reshape(B_, L, G * R, v.shape[-1])


def _complex_affine_combine(e1, e2):
    a1r, a1i, b1r, b1i = e1
    a2r, a2i, b2r, b2i = e2
    return (a2r * a1r - a2i * a1i, a2r * a1i + a2i * a1r,
            a2r * b1r - a2i * b1i + b2r, a2r * b1i + a2i * b1r + b2i)


def s5_direction(u, lam_re, lam_im, log_dt, b_re, b_im, c_re, c_im, s0_re, s0_im, reverse):
    dt = jnp.exp(log_dt)[:, None]
    decay = jnp.exp(lam_re * dt)
    ab_re = decay * jnp.cos(lam_im * dt)
    ab_im = decay * jnp.sin(lam_im * dt)
    den = lam_re * lam_re + lam_im * lam_im
    num_re = ab_re - 1.0
    coef_re = (num_re * lam_re + ab_im * lam_im) / den
    coef_im = (ab_im * lam_re - num_re * lam_im) / den
    bb_re = coef_re[..., None] * b_re - coef_im[..., None] * b_im
    bb_im = coef_re[..., None] * b_im + coef_im[..., None] * b_re
    bu_re = jnp.einsum('gph,blgh->blgp', bb_re, u)
    bu_im = jnp.einsum('gph,blgh->blgp', bb_im, u)
    L = u.shape[1]
    if s0_re is not None:
        first = L - 1 if reverse else 0
        bu_re = bu_re.at[:, first].add(ab_re * s0_re - ab_im * s0_im)
        bu_im = bu_im.at[:, first].add(ab_re * s0_im + ab_im * s0_re)
    a_re = jnp.broadcast_to(ab_re, (1, L) + ab_re.shape)
    a_im = jnp.broadcast_to(ab_im, (1, L) + ab_im.shape)
    _, _, s_re, s_im = lax.associative_scan(_complex_affine_combine, (a_re, a_im, bu_re, bu_im),
                                            reverse=reverse, axis=1)
    y = jnp.einsum('ghp,blgp->blgh', c_re, s_re) - jnp.einsum('ghp,blgp->blgh', c_im, s_im)
    last = 0 if reverse else L - 1
    return y, s_re[:, last], s_im[:, last]


def s5_mixer(u, lp, s0_re, s0_im):
    f32 = jnp.float32
    B_, L, _ = u.shape
    uf = u.astype(f32).reshape(B_, L, SSM_GROUPS, SSM_GROUP_CH)
    y = lp['ssm_d'].astype(f32).reshape(SSM_GROUPS, SSM_GROUP_CH) * uf
    fin_re, fin_im = [], []
    for d, rev in enumerate((False, True)):
        yd, fr, fi = s5_direction(
            uf, lp['ssm_lam_re'][d].astype(f32), lp['ssm_lam_im'][d].astype(f32),
            lp['ssm_log_dt'][d].astype(f32), lp['ssm_b_re'][d].astype(f32), lp['ssm_b_im'][d].astype(f32),
            lp['ssm_c_re'][d].astype(f32), lp['ssm_c_im'][d].astype(f32),
            None if s0_re is None else s0_re[:, d].astype(f32),
            None if s0_im is None else s0_im[:, d].astype(f32), rev)
        y = y + yd
        fin_re.append(fr)
        fin_im.append(fi)
    y = jax.nn.gelu(y.reshape(B_, L, SSM_CH))
    y = y * jax.nn.sigmoid(y @ lp['ssm_w_glu'].astype(f32) + lp['ssm_b_glu'].astype(f32))
    return y.astype(u.dtype), jnp.stack(fin_re, axis=1), jnp.stack(fin_im, axis=1)


def trunk_layer(x, cond, lp, ctx):
    B_, L, _ = x.shape
    shift1, scale1, gate1, shift2, scale2, gate2 = adaln(cond, lp['w_ada'], lp['b_ada'])
    h = rms_norm(x, lp['norm1_g']) * (1.0 + scale1) + shift1
    gq, gk, gv, cq, ckv, kr, u = jnp.split(h @ lp['w_in'], IN_OFFSETS, axis=-1)
    q_a = rms_norm(gq.reshape(B_, L, GQA_HEADS, GQA_HEAD_DIM), lp['gqa_q_norm'])
    k_a = rms_norm(gk.reshape(B_, L, GQA_KV_HEADS, GQA_HEAD_DIM), lp['gqa_k_norm'])
    v_a = gv.reshape(B_, L, GQA_KV_HEADS, GQA_HEAD_DIM)
    q_b = (rms_norm(cq, lp['mla_q_norm']) @ lp['mla_w_uq']).reshape(B_, L, MLA_HEADS, MLA_QK_DIM)
    ckv = rms_norm(ckv, lp['mla_kv_norm'])
    ctx_out = (k_a, v_a, ckv, kr)
    if ctx is None:
        keys_a, vals_a, ckv_all, kr_all = k_a, v_a, ckv, kr
        s0_re = s0_im = None
    else:
        ck, cv, cckv, ckr, s0_re, s0_im = ctx
        cos_a, sin_a = axial_rope(L, GQA_HEAD_DIM)
        cos_b, sin_b = axial_rope(L, MLA_ROPE_DIM)
        q_a = apply_rope(q_a, cos_a, sin_a)
        keys_a = jnp.concatenate([apply_rope(k_a, cos_a, sin_a), ck], axis=1)
        vals_a = jnp.concatenate([v_a, cv], axis=1)
        q_b = jnp.concatenate([q_b[..., :MLA_NOPE_DIM],
                               apply_rope(q_b[..., MLA_NOPE_DIM:], cos_b, sin_b)], axis=-1)
        kr_lat = apply_rope(kr[:, :, None, :], cos_b, sin_b)[:, :, 0, :]
        ckv_all = jnp.concatenate([ckv, cckv], axis=1)
        kr_all = jnp.concatenate([kr_lat, ckr], axis=1)
    Lk = keys_a.shape[1]
    o_a = block_attention(q_a.reshape(B_, L, GQA_KV_HEADS, GQA_REP, GQA_HEAD_DIM),
                          keys_a, vals_a, GQA_HEAD_DIM ** -0.5)
    k_nope = (ckv_all @ lp['mla_w_uk']).reshape(B_, Lk, MLA_HEADS, MLA_NOPE_DIM)
    v_b = (ckv_all @ lp['mla_w_uv']).reshape(B_, Lk, MLA_HEADS, MLA_V_DIM)
    k_b = jnp.concatenate([k_nope, jnp.broadcast_to(kr_all[:, :, None, :],
                                                    (B_, Lk, MLA_HEADS, MLA_ROPE_DIM))], axis=-1)
    o_b = block_attention(q_b[:, :, :, None, :], k_b, v_b, MLA_QK_DIM ** -0.5)
    o_c, s_re, s_im = s5_mixer(u, lp, s0_re, s0_im)
    mix = jnp.concatenate([o_a.reshape(B_, L, GQA_OUT), o_b.reshape(B_, L, MLA_OUT), o_c], axis=-1)
    x = x + gate1 * (mix @ lp['w_out'])
    h2 = rms_norm(x, lp['norm2_g']) * (1.0 + scale2) + shift2
    g, up = jnp.split(h2 @ lp['w_ffn_in'], 2, axis=-1)
    x = x + gate2 * ((jax.nn.silu(g) * up) @ lp['w_ffn_out'])
    return x, ctx_out + (s_re, s_im)


def setup_inputs(seed: int = 0) -> dict:
    key = jax.random.key(seed)
    ks = jax.random.split(key, 36)
    f32 = jnp.float32

    def nrm(i, shape, scale=1.0):
        return jax.random.normal(ks[i], shape, f32) * scale

    G, H, P = SSM_GROUPS, SSM_GROUP_CH, SSM_STATE
    lam_im0 = math.pi * jnp.arange(P, dtype=f32)
    return {
        'x_prompt': nrm(0, (BATCH, SEQ, D_MODEL)),
        'x_sample': nrm(1, (DEC_BATCH, DEC_SEQ, D_MODEL)),
        'cache_gqa_k': nrm(2, (DEC_BATCH, DEPTH, PAST_LEN, GQA_KV_HEADS, GQA_HEAD_DIM)),
        'cache_gqa_v': nrm(3, (DEC_BATCH, DEPTH, PAST_LEN, GQA_KV_HEADS, GQA_HEAD_DIM)),
        'cache_mla_ckv': nrm(4, (DEC_BATCH, DEPTH, PAST_LEN, MLA_KV_RANK)),
        'cache_mla_krope': nrm(5, (DEC_BATCH, DEPTH, PAST_LEN, MLA_ROPE_DIM)),
        'state_ssm_re': nrm(6, (DEC_BATCH, DEPTH, 2, G, P), 0.5),
        'state_ssm_im': nrm(7, (DEC_BATCH, DEPTH, 2, G, P), 0.5),
        'c': nrm(8, (DEC_BATCH, D_MODEL)),
        'c_ctx': nrm(9, (D_MODEL,)),
        'norm1_g': 1.0 + nrm(10, (DEPTH, D_MODEL), 0.02),
        'norm2_g': 1.0 + nrm(11, (DEPTH, D_MODEL), 0.02),
        'w_ada': nrm(12, (DEPTH, D_MODEL, 6 * D_MODEL), 0.5 * D_MODEL ** -0.5),
        'b_ada': nrm(13, (DEPTH, 6 * D_MODEL), 0.01),
        'w_in': nrm(14, (DEPTH, D_MODEL, IN_WIDTH), D_MODEL ** -0.5),
        'gqa_q_norm': 1.0 + nrm(15, (DEPTH, GQA_HEAD_DIM), 0.02),
        'gqa_k_norm': 1.0 + nrm(16, (DEPTH, GQA_HEAD_DIM), 0.02),
        'mla_q_norm': 1.0 + nrm(17, (DEPTH, MLA_Q_RANK), 0.02),
        'mla_kv_norm': 1.0 + nrm(18, (DEPTH, MLA_KV_RANK), 0.02),
        'mla_w_uq': nrm(19, (DEPTH, MLA_Q_RANK, MLA_HEADS * MLA_QK_DIM), MLA_Q_RANK ** -0.5),
        'mla_w_uk': nrm(20, (DEPTH, MLA_KV_RANK, MLA_HEADS * MLA_NOPE_DIM), MLA_KV_RANK ** -0.5),
        'mla_w_uv': nrm(21, (DEPTH, MLA_KV_RANK, MLA_HEADS * MLA_V_DIM), MLA_KV_RANK ** -0.5),
        'ssm_lam_re': -0.5 + nrm(22, (DEPTH, 2, G, P), 0.01),
        'ssm_lam_im': lam_im0 + nrm(23, (DEPTH, 2, G, P), 0.01),
        'ssm_log_dt': jax.random.uniform(ks[24], (DEPTH, 2, G), f32, math.log(1e-3), math.log(1e-1)),
        'ssm_b_re': nrm(25, (DEPTH, 2, G, P, H), (2 * H) ** -0.5),
        'ssm_b_im': nrm(26, (DEPTH, 2, G, P, H), (2 * H) ** -0.5),
        'ssm_c_re': nrm(27, (DEPTH, 2, G, H, P), (2 * P) ** -0.5),
        'ssm_c_im': nrm(28, (DEPTH, 2, G, H, P), (2 * P) ** -0.5),
        'ssm_d': nrm(29, (DEPTH, SSM_CH)),
        'ssm_w_glu': nrm(30, (DEPTH, SSM_CH, SSM_CH), SSM_CH ** -0.5),
        'ssm_b_glu': nrm(31, (DEPTH, SSM_CH), 0.01),
        'w_out': nrm(32, (DEPTH, MIX_WIDTH, D_MODEL), MIX_WIDTH ** -0.5),
        'w_ffn_in': nrm(33, (DEPTH, D_MODEL, 2 * D_FF), D_MODEL ** -0.5),
        'w_ffn_out': nrm(34, (DEPTH, D_FF, D_MODEL), D_FF ** -0.5),
        'final_g': 1.0 + nrm(35, (D_MODEL,), 0.02),
    }


def reference(x_prompt, x_sample, cache_gqa_k, cache_gqa_v, cache_mla_ckv, cache_mla_krope,
              state_ssm_re, state_ssm_im, c, c_ctx, norm1_g, norm2_g, w_ada, b_ada, w_in,
              gqa_q_norm, gqa_k_norm, mla_q_norm, mla_kv_norm, mla_w_uq, mla_w_uk, mla_w_uv,
              ssm_lam_re, ssm_lam_im, ssm_log_dt, ssm_b_re, ssm_b_im, ssm_c_re, ssm_c_im,
              ssm_d, ssm_w_glu, ssm_b_glu, w_out, w_ffn_in, w_ffn_out, final_g):
    xp, xs = x_prompt, x_sample
    ks_, vs_, ckvs_, krs_, sres_, sims_ = [], [], [], [], [], []
    for l in range(DEPTH):
        lp = {
            'norm1_g': norm1_g[l], 'norm2_g': norm2_g[l], 'w_ada': w_ada[l], 'b_ada': b_ada[l],
            'w_in': w_in[l], 'gqa_q_norm': gqa_q_norm[l], 'gqa_k_norm': gqa_k_norm[l],
            'mla_q_norm': mla_q_norm[l], 'mla_kv_norm': mla_kv_norm[l], 'mla_w_uq': mla_w_uq[l],
            'mla_w_uk': mla_w_uk[l], 'mla_w_uv': mla_w_uv[l], 'ssm_lam_re': ssm_lam_re[l],
            'ssm_lam_im': ssm_lam_im[l], 'ssm_log_dt': ssm_log_dt[l], 'ssm_b_re': ssm_b_re[l],
            'ssm_b_im': ssm_b_im[l], 'ssm_c_re': ssm_c_re[l], 'ssm_c_im': ssm_c_im[l],
            'ssm_d': ssm_d[l], 'ssm_w_glu': ssm_w_glu[l], 'ssm_b_glu': ssm_b_glu[l],
            'w_out': w_out[l], 'w_ffn_in': w_ffn_in[l], 'w_ffn_out': w_ffn_out[l],
        }
        xp, (k_c, v_c, ckv_c, kr_c, sr_c, si_c) = trunk_layer(xp, c_ctx, lp, None)
        ks_.append(k_c)
        vs_.append(v_c)
        ckvs_.append(ckv_c)
        krs_.append(kr_c)
        sres_.append(sr_c)
        sims_.append(si_c)
        ctx = (cache_gqa_k[:, l], cache_gqa_v[:, l], cache_mla_ckv[:, l], cache_mla_krope[:, l],
               state_ssm_re[:, l], state_ssm_im[:, l])
        xs, _ = trunk_layer(xs, c, lp, ctx)
    y_prompt = rms_norm(xp, final_g)
    y_sample = rms_norm(xs, final_g)
    new_gqa_k = jnp.stack(ks_, axis=1)
    new_gqa_v = jnp.stack(vs_, axis=1)
    new_mla_ckv = jnp.stack(ckvs_, axis=1)
    new_mla_krope = jnp.stack(krs_, axis=1)
    new_ssm_re = jnp.stack(sres_, axis=1)
    new_ssm_im = jnp.stack(sims_, axis=1)
    return (y_prompt, y_sample, new_gqa_k, new_gqa_v, new_mla_ckv, new_mla_krope, new_ssm_re, new_ssm_im)
```

```cpp
#include <hip/hip_runtime.h>
#include <hip/hip_cooperative_groups.h>
#include <cstdio>
#include <cstdint>
namespace cg = cooperative_groups;
namespace pg8 {
#define PG8_LAS __attribute__((address_space(3)))
typedef unsigned short bf16_t;
typedef short bf16x8 __attribute__((ext_vector_type(8)));
typedef float f32x4 __attribute__((ext_vector_type(4)));
typedef unsigned u32x4 __attribute__((ext_vector_type(4)));
constexpr int BM = 256, BK = 64, HALF = 128, HTB = HALF * BK * 2  , STAGE_BYTES = 8 * HTB, NXCD = 8, WGM = 8;

__host__ __device__ __forceinline__ int lds_byte(int r, int c) { const int st = (r >> 4) * 2 + (c >> 5), rr = r & 15, cc = c & 31, ob = rr * 64 + cc * 2; return st * 1024 + (ob ^ (((ob >> 9) & 1) << 5)); }
__host__ __device__ __forceinline__ void stage_rc(int b, int& R, int& C) { const int st = b / 1024, sb = b % 1024, swz = sb ^ (((sb >> 9) & 1) << 5); R = (st >> 1) * 16 + swz / 64; C = (st & 1) * 32 + (swz % 64) / 2; }
__host__ __device__ __forceinline__ int perm32(int rho) { const int n = rho >> 4, i = rho & 15; return 8 * (i >> 2) + 4 * n + (i & 3); }

struct Unit { int pm, pn; };
struct Gemm { const bf16_t* A; const bf16_t* Bt; int M, N, K; };

struct StaticOrder {
    int nM, nN, nwg, G, c;
    __host__ __device__ void init(int M, int N, int G_, int c_) { nM = M / BM; nN = N / BM; nwg = nM * nN; G = G_; c = c_; }
    __host__ __device__ bool next(int i, Unit& u) const {
        const long L = (long)i * G + c; if (L >= nwg) return false;
        int wgid = (int)L; { const int q = nwg / NXCD, r = nwg % NXCD, xcd = wgid % NXCD, off = wgid / NXCD; wgid = (xcd < r ? xcd * (q + 1) : r * (q + 1) + (xcd - r) * q) + off; }
        const int nig = WGM * nN, gid = wgid / nig, fm = gid * WGM, gsz = (nM - fm) < WGM ? (nM - fm) : WGM;
        u.pm = fm + ((wgid % nig) % gsz); u.pn = (wgid % nig) / gsz; return true;
    }
    __device__ __forceinline__ void a_ready(const Unit&) const {}
    __device__ __forceinline__ void done(const Unit&) const {}
};

__device__ __forceinline__ unsigned cvt_pk_bf16(float lo, float hi) { unsigned r; asm volatile("v_cvt_pk_bf16_f32 %0, %1, %2" : "=v"(r) : "v"(lo), "v"(hi)); return r; }
typedef float f32x2 __attribute__((ext_vector_type(2)));
__device__ __forceinline__ f32x2 gelu_pk(f32x2 v) {
    const f32x2 av = __builtin_elementwise_abs(v), d = av * 0.2316418882f + 1.0f;
    f32x2 t; t.x = __builtin_amdgcn_rcpf(d.x); t.y = __builtin_amdgcn_rcpf(d.y);
    f32x2 q = t * 0.5307027145f + (-0.7265760135f); q = q * t + 0.7107068705f; q = q * t + (-0.142248368f); q = q * t + 0.127414796f; q = q * t;
    const f32x2 s = (v * v) * (-0.72134752044f);
    f32x2 e; e.x = __builtin_amdgcn_exp2f(s.x); e.y = __builtin_amdgcn_exp2f(s.y);
    const f32x2 m = v * (q * e), r = v - m;
    f32x2 o; o.x = v.x < 0.f ? m.x : r.x; o.y = v.y < 0.f ? m.y : r.y; return o;
}

template <int ACT  > struct EpiBf16 {
    static constexpr bool PERM = true, AFTER_DRAIN = false; static_assert(ACT == 0 || ACT == 1, "EpiBf16: ACT is 0 (none) or 1 (gelu_pk)");
    bf16_t* O; int ldc; const float* bias; int split_cols; size_t split_stride; float scale0;
    __device__ __forceinline__ void operator()(const f32x4 (&acc)[2][2][4][2], const Unit& u, int wr, int wc, int fr, int fq) const {
        const int row0 = u.pm * BM + wr * 64 + fr; int colt = u.pn * BM; bf16_t* base = O;
        float sc = 1.f; if (split_cols) { const int t = colt / split_cols; base += (size_t)t * split_stride; colt -= t * split_cols; if (t == 0) sc = scale0; }
        const int col0 = colt + wc * 32 + 8 * fq, bcol0 = u.pn * BM + wc * 32 + 8 * fq;
        f32x4 bv[2][2];
#pragma unroll
        for (int bj = 0; bj < 2; ++bj)
#pragma unroll
            for (int n = 0; n < 2; ++n) bv[bj][n] = bias ? *(const f32x4*)(bias + bcol0 + bj * HALF + 4 * n) : (f32x4){0.f, 0.f, 0.f, 0.f};
#pragma unroll
        for (int ai = 0; ai < 2; ++ai)
#pragma unroll
            for (int m = 0; m < 4; ++m) { bf16_t* rowp = base + (size_t)(row0 + ai * HALF + m * 16) * ldc + col0;
#pragma unroll
                for (int bj = 0; bj < 2; ++bj) { f32x4 v0 = acc[ai][bj][m][0] + bv[bj][0], v1 = acc[ai][bj][m][1] + bv[bj][1];
                    if (ACT == 1) { f32x2 a = gelu_pk((f32x2){v0[0], v0[1]}), b = gelu_pk((f32x2){v0[2], v0[3]}), c = gelu_pk((f32x2){v1[0], v1[1]}), d = gelu_pk((f32x2){v1[2], v1[3]});
                        v0 = (f32x4){a.x, a.y, b.x, b.y}; v1 = (f32x4){c.x, c.y, d.x, d.y}; }
                    v0 = v0 * sc; v1 = v1 * sc; u32x4 w; w.x = cvt_pk_bf16(v0[0], v0[1]); w.y = cvt_pk_bf16(v0[2], v0[3]); w.z = cvt_pk_bf16(v1[0], v1[1]); w.w = cvt_pk_bf16(v1[2], v1[3]);
                    *(u32x4*)(rowp + bj * HALF) = w; } }
    }
};
template <class Epi, class Sched, bool ALIGN_EPI = false, bool SP2 = false>
__device__ __forceinline__ void gemm_phase(PG8_LAS unsigned char* lds, const Gemm g, const Sched& S, const Epi& E) {
    int tid_ = threadIdx.x; asm volatile("" : "+v"(tid_));
    const int tid = tid_, wid = __builtin_amdgcn_readfirstlane(tid >> 6), lane = tid & 63, wr = wid >> 2, wc = wid & 3, fr = lane & 15, fq = lane >> 4;
    const int K = g.K, nt = K / BK;
    unsigned voffA[2], voffB[2];
#pragma unroll
    for (int i = 0; i < 2; ++i) { int R, C; stage_rc(tid * 16 + i * 8192, R, C); const int Rb = Epi::PERM ? ((R & ~31) + perm32(R & 31)) : R;
        voffA[i] = (unsigned)(R * K + C) * 2u; voffB[i] = (unsigned)(Rb * K + C) * 2u; }
    const size_t kstep = (size_t)(BK * 2);
    const size_t hstep = (size_t)HALF * K * 2;
    const size_t tstep = 2 * hstep;
    const unsigned ldsw = (unsigned)wid * 1024u;
    const int aoff = lds_byte(wr * 64 + fr, fq * 8), boff = lds_byte(wc * 32 + fr, fq * 8);
#define PG8_SA(b, h) (((b) * 2 + (h)) * HTB)
#define PG8_SB(b, h) ((4 + (b) * 2 + (h)) * HTB)
#define PG8_STAGE(bufoff, gbase, voff) do { _Pragma("unroll") for (int _i = 0; _i < 2; ++_i) \
        __builtin_amdgcn_global_load_lds((const unsigned*)((const char*)(gbase) + (voff)[_i]), (PG8_LAS unsigned*)(lds + (bufoff) + ldsw + _i * 8192), 16, 0, 0); } while (0)
#define PG8_LDA(dst, b, h) do { _Pragma("unroll") for (int m = 0; m < 4; ++m) _Pragma("unroll") for (int k = 0; k < 2; ++k) dst[m][k] = *(const PG8_LAS bf16x8*)(lds + PG8_SA(b, h) + aoff + m * 2048 + k * 1024); } while (0)
#define PG8_LDB(dst, b, h) do { _Pragma("unroll") for (int n = 0; n < 2; ++n) _Pragma("unroll") for (int k = 0; k < 2; ++k) dst[n][k] = *(const PG8_LAS bf16x8*)(lds + PG8_SB(b, h) + boff + n * 2048 + k * 1024); } while (0)
#define PG8_MMA(ai, bj, At, Bt) do { __builtin_amdgcn_s_setprio(1); _Pragma("unroll") for (int m = 0; m < 4; ++m) _Pragma("unroll") for (int n = 0; n < 2; ++n) _Pragma("unroll") for (int k = 0; k < 2; ++k) \
        acc[ai][bj][m][n] = __builtin_amdgcn_mfma_f32_16x16x32_bf16(Bt[n][k], At[m][k], acc[ai][bj][m][n], 0, 0, 0); __builtin_amdgcn_s_setprio(0); } while (0)
#define PG8_WAIT_V(n) asm volatile("s_waitcnt vmcnt(" #n ")" ::: "memory")
#define PG8_WAIT_L(n) asm volatile("s_waitcnt lgkmcnt(" #n ")" ::: "memory")
#define PG8_BAR __builtin_amdgcn_s_barrier()
#define PG8_SCHED __builtin_amdgcn_sched_barrier(0)
    Unit cur, nxt; int ui = 0;
    if (!S.next(0, cur)) return;
    f32x4 acc[2][2][4][2];
#pragma unroll
    for (int a = 0; a < 2; ++a)
#pragma unroll
        for (int b = 0; b < 2; ++b)
#pragma unroll
            for (int m = 0; m < 4; ++m)
#pragma unroll
                for (int n = 0; n < 2; ++n) acc[a][b][m][n] = (f32x4){0.f, 0.f, 0.f, 0.f};
    bf16x8 At[4][2], B0[2][2], B1[2][2];
    const char* cA = (const char*)g.A + (size_t)cur.pm * tstep; const char* cB = (const char*)g.Bt + (size_t)cur.pn * tstep;
    S.a_ready(cur);
    if constexpr (SP2) {
        PG8_STAGE(PG8_SB(0, 0), cB, voffB); PG8_STAGE(PG8_SB(0, 1), cB + hstep, voffB); PG8_STAGE(PG8_SA(0, 0), cA, voffA); PG8_STAGE(PG8_SA(0, 1), cA + hstep, voffA);
        if (wr == 1) PG8_BAR;
        PG8_WAIT_V(2); PG8_BAR;
        PG8_STAGE(PG8_SB(1, 0), cB + kstep, voffB); PG8_STAGE(PG8_SA(1, 0), cA + kstep, voffA); PG8_STAGE(PG8_SB(1, 1), cB + hstep + kstep, voffB);
        PG8_WAIT_V(6); PG8_BAR;
    } else {
        PG8_STAGE(PG8_SB(0, 0), cB, voffB); PG8_STAGE(PG8_SA(0, 0), cA, voffA); PG8_STAGE(PG8_SB(0, 1), cB + hstep, voffB); PG8_STAGE(PG8_SA(0, 1), cA + hstep, voffA);
        if (wr == 1) PG8_BAR;
        PG8_WAIT_V(4); PG8_BAR;
        PG8_STAGE(PG8_SB(1, 0), cB + kstep, voffB); PG8_STAGE(PG8_SA(1, 0), cA + kstep, voffA); PG8_STAGE(PG8_SB(1, 1), cB + hstep + kstep, voffB);
        PG8_WAIT_V(6); PG8_BAR;
    }
    for (;;) {
        const bool has_next = S.next(ui + 1, nxt);
        const char* nA = has_next ? (const char*)g.A + (size_t)nxt.pm * tstep : cA; const char* nB = has_next ? (const char*)g.Bt + (size_t)nxt.pn * tstep : cB;
        for (int t = 0; t < nt; t += 2) {
            const bool last = (t == nt - 2);
            const char* a1 = cA + (size_t)(t + 1) * kstep;
            const char* a2 = last ? nA : cA + (size_t)(t + 2) * kstep; const char* b2 = last ? nB : cB + (size_t)(t + 2) * kstep;
            const char* a3 = a2 + kstep; const char* b3 = b2 + kstep;
            if (last && has_next) S.a_ready(nxt);
            if constexpr (SP2) {
            PG8_LDB(B0, 0, 0); PG8_LDB(B1, 0, 1); PG8_SCHED; PG8_LDA(At, 0, 0); PG8_STAGE(PG8_SA(1, 1), a1 + hstep, voffA);
            PG8_WAIT_V(8); PG8_WAIT_L(0); PG8_BAR; PG8_MMA(0, 0, At, B0); PG8_MMA(0, 1, At, B1); PG8_BAR; PG8_SCHED;
            PG8_LDA(At, 0, 1); PG8_STAGE(PG8_SB(0, 0), b2, voffB); PG8_STAGE(PG8_SB(0, 1), b2 + hstep, voffB); PG8_STAGE(PG8_SA(0, 0), a2, voffA);
            PG8_WAIT_V(8); PG8_WAIT_L(0); PG8_BAR; PG8_MMA(1, 0, At, B0); PG8_MMA(1, 1, At, B1); PG8_BAR; PG8_SCHED;
            PG8_LDB(B0, 1, 0); PG8_LDB(B1, 1, 1); PG8_SCHED; PG8_LDA(At, 1, 0); PG8_STAGE(PG8_SA(0, 1), a2 + hstep, voffA);
            PG8_WAIT_V(8); PG8_WAIT_L(0); PG8_BAR; PG8_MMA(0, 0, At, B0); PG8_MMA(0, 1, At, B1); PG8_BAR; PG8_SCHED;
            PG8_LDA(At, 1, 1); PG8_STAGE(PG8_SB(1, 0), b3, voffB); PG8_STAGE(PG8_SB(1, 1), b3 + hstep, voffB); PG8_STAGE(PG8_SA(1, 0), a3, voffA);
            PG8_WAIT_V(8); PG8_WAIT_L(0); PG8_BAR; PG8_MMA(1, 0, At, B0); PG8_MMA(1, 1, At, B1); PG8_BAR; PG8_SCHED;
            } else {
            PG8_LDB(B0, 0, 0); PG8_SCHED; PG8_LDA(At, 0, 0); PG8_STAGE(PG8_SA(1, 1), a1 + hstep, voffA);
            PG8_WAIT_L(8); PG8_BAR; PG8_WAIT_L(0); PG8_MMA(0, 0, At, B0); PG8_BAR; PG8_SCHED;
            PG8_LDB(B1, 0, 1); PG8_STAGE(PG8_SB(0, 0), b2, voffB);
            PG8_BAR; PG8_WAIT_L(0); PG8_MMA(0, 1, At, B1); PG8_BAR;
            PG8_LDA(At, 0, 1); PG8_STAGE(PG8_SA(0, 0), a2, voffA);
            PG8_BAR; PG8_WAIT_L(0); PG8_MMA(1, 0, At, B0); PG8_BAR; PG8_SCHED;
            PG8_STAGE(PG8_SB(0, 1), b2 + hstep, voffB);
            PG8_WAIT_V(6); PG8_BAR; PG8_MMA(1, 1, At, B1); PG8_BAR;
            PG8_LDB(B0, 1, 0); PG8_SCHED; PG8_LDA(At, 1, 0); PG8_STAGE(PG8_SA(0, 1), a2 + hstep, voffA);
            PG8_WAIT_L(8); PG8_BAR; PG8_WAIT_L(0); PG8_MMA(0, 0, At, B0); PG8_BAR; PG8_SCHED;
            PG8_LDB(B1, 1, 1); PG8_STAGE(PG8_SB(1, 0), b3, voffB);
            PG8_BAR; PG8_WAIT_L(0); PG8_MMA(0, 1, At, B1); PG8_BAR;
            PG8_LDA(At, 1, 1); PG8_STAGE(PG8_SA(1, 0), a3, voffA);
            PG8_BAR; PG8_WAIT_L(0); PG8_MMA(1, 0, At, B0); PG8_BAR; PG8_SCHED;
            PG8_STAGE(PG8_SB(1, 1), b3 + hstep, voffB);
            PG8_WAIT_V(6); PG8_BAR; PG8_MMA(1, 1, At, B1); PG8_BAR;
            }
        }
        if constexpr (ALIGN_EPI) { if (wr == 0) PG8_BAR; }
        if constexpr (!Epi::AFTER_DRAIN) { E(acc, cur, wr, wc, fr, fq); S.done(cur); }
        if (!has_next) break;
#pragma unroll
        for (int a = 0; a < 2; ++a)
#pragma unroll
            for (int b = 0; b < 2; ++b)
#pragma unroll
                for (int m = 0; m < 4; ++m)
#pragma unroll
                    for (int n = 0; n < 2; ++n) acc[a][b][m][n] = (f32x4){0.f, 0.f, 0.f, 0.f};
        cur = nxt; cA = nA; cB = nB; ++ui;
        if constexpr (ALIGN_EPI) { if (wr == 1) PG8_BAR; }
    }
    PG8_WAIT_V(0);
    if constexpr (!ALIGN_EPI) { if (wr == 0) PG8_BAR; }
    PG8_BAR;
    if constexpr (Epi::AFTER_DRAIN) { E.fused(acc, cur, wr, wc, fr, fq, lds, wid, lane); S.done(cur); }
#undef PG8_SA
#undef PG8_SB
#undef PG8_STAGE
#undef PG8_LDA
#undef PG8_LDB
#undef PG8_MMA
#undef PG8_WAIT_V
#undef PG8_WAIT_L
#undef PG8_BAR
#undef PG8_SCHED
}
}

#define DI __device__ __forceinline__
#define LAS __attribute__((address_space(3)))
typedef unsigned short bf16;
typedef short bf16x8 __attribute__((ext_vector_type(8)));
typedef float f32x4 __attribute__((ext_vector_type(4)));
typedef float f32x2 __attribute__((ext_vector_type(2)));
typedef float f32x16 __attribute__((ext_vector_type(16)));
typedef unsigned u32x4 __attribute__((ext_vector_type(4)));
typedef unsigned u32x2 __attribute__((ext_vector_type(2)));
typedef __bf16 bf16x2_t __attribute__((ext_vector_type(2)));

constexpr int DM = 1024, NPB = 16, NPL = 256, NSB = 8, NSL = 4096, PAST = 512, NLAYER = 4;
constexpr int MP = NPB * NPL;
constexpr int MS = NSB * NSL;
constexpr int MT = MP + MS;
constexpr int NINP = 1536, DFF = 2816, NF1 = 5632;
constexpr int LKS = NSL + PAST;
constexpr int KROWS = MP + NSB * LKS;
constexpr float EPS = 1e-6f;
constexpr float QSC_A = 0.125f * 1.4426950408889634f;
constexpr float QSC_B = 0.10206207261596575f * 1.4426950408889634f;
constexpr int LDS_BYTES = 147456;
constexpr int NPHASE = 3 + 9 * NLAYER;

constexpr size_t O_K = (size_t)MT * 1024, O_V = O_K + 2097152, O_CKV = O_V + 2097152, O_KR = O_CKV + 2097152, O_SRE = O_KR + 524288, O_SIM = O_SRE + 131072;

constexpr size_t WS_WIN = 0;
constexpr size_t WS_WOUT = WS_WIN + 4ull * 1536 * 1024 * 2;
constexpr size_t WS_WF1 = WS_WOUT + 4ull * 1024 * 1024 * 2;
constexpr size_t WS_WF2 = WS_WF1 + 4ull * 5632 * 1024 * 2;
constexpr size_t WS_WUQ = WS_WF2 + 4ull * 1024 * 2816 * 2;
constexpr size_t WS_WUKV = WS_WUQ + 4ull * 576 * 256 * 2;
constexpr size_t WS_WGLU = WS_WUKV + 4ull * 768 * 128 * 2;
constexpr size_t WS_MODP = WS_WGLU + 4ull * 256 * 256 * 2;
constexpr size_t WS_MOD = WS_MODP + 4ull * 8 * 9 * 6144 * 4;
constexpr size_t WS_H = WS_MOD + 4ull * 9 * 6144 * 4;
constexpr size_t WS_U0 = WS_H + (size_t)MT * 1024 * 2;
constexpr size_t WS_PROJ = WS_U0;
constexpr size_t WS_QA = WS_PROJ + (size_t)MT * 1536 * 2;
constexpr size_t WS_QB = WS_QA + (size_t)MT * 384 * 2;
constexpr size_t WS_KA = WS_QB + (size_t)MT * 576 * 2;
constexpr size_t WS_VTA = WS_KA + (size_t)KROWS * 128 * 2;
constexpr size_t WS_KB = WS_VTA + (size_t)KROWS * 128 * 2;
constexpr size_t WS_VTB = WS_KB + (size_t)KROWS * 576 * 2;
constexpr size_t WS_UU = WS_VTB + (size_t)KROWS * 384 * 2;
constexpr size_t WS_END = WS_UU + (size_t)MT * 256 * 2;
constexpr size_t WS_BAR = WS_END;
constexpr size_t WS_TOTAL = WS_END + 16384;
constexpr size_t WS_HDN = WS_U0;
static_assert(WS_HDN + (size_t)MT * 2816 * 2 <= WS_END, "hdn overlay");
static_assert(WS_TOTAL <= 536870912ull, "ws budget");

struct Args { const float* in[36]; float* out; unsigned char* ws; int ph_lo, ph_hi; };

DI unsigned pk2(float lo, float hi) { f32x2 v = {lo, hi}; bf16x2_t b = __builtin_convertvector(v, bf16x2_t); return __builtin_bit_cast(unsigned, b); }
DI unsigned short f2bf(float f) { return (unsigned short)(pk2(f, 0.f) & 0xffffu); }
DI float bf2f(unsigned short b) { return __uint_as_float(((unsigned)b) << 16); }
DI float bflo(unsigned u) { return __uint_as_float(u << 16); }
DI float bfhi(unsigned u) { return __uint_as_float(u & 0xffff0000u); }
DI float wave_sum(float v) {
#pragma unroll
    for (int o = 1; o < 64; o <<= 1) v += __shfl_xor(v, o);
    return v;
}
DI int crow(int r, int hi) { return (r & 3) + 8 * (r >> 2) + 4 * hi; }
DI int swap23(int r) { return (r & ~12) | ((r & 4) << 1) | ((r & 8) >> 1); }
DI int cond_of_row(int m) { return m < MP ? 0 : 1 + ((m - MP) >> 12); }
DI float rsq(float x) { return 1.0f / sqrtf(x); }
DI void sincos_acc(float y, float& s, float& c) {
    const float n = rintf(y * 0.6366197723675814f);
    float r = fmaf(n, -1.5707962513e+00f, y); r = fmaf(n, -7.5497894159e-08f, r); r = fmaf(n, -5.3903029534e-15f, r);
    const float r2 = r * r;
    float sp = fmaf(r2, 2.7557319e-6f, -1.9841270e-4f); sp = fmaf(sp, r2, 8.3333333e-3f); sp = fmaf(sp, r2, -1.6666667e-1f); sp = fmaf(sp * r2, r, r);
    float cp = fmaf(r2, 2.4801587e-5f, -1.3888889e-3f); cp = fmaf(cp, r2, 4.1666667e-2f); cp = fmaf(cp, r2, -0.5f); cp = fmaf(cp, r2, 1.0f);
    const int q = ((int)n) & 3;
    const float ss = (q & 1) ? cp : sp, cc = (q & 1) ? sp : cp;
    s = (q & 2) ? -ss : ss; c = ((q + 1) & 2) ? -cc : cc;
}
DI float expm1_acc(float x) {
    if (fabsf(x) < 0.35f) { float p = fmaf(x, 1.f / 40320.f, 1.f / 5040.f); p = fmaf(p, x, 1.f / 720.f); p = fmaf(p, x, 1.f / 120.f); p = fmaf(p, x, 1.f / 24.f); p = fmaf(p, x, 1.f / 6.f); p = fmaf(p, x, 0.5f); return fmaf(p * x, x, x); }
    return expf(x) - 1.f;
}
#define MFMA32(a, b, c) __builtin_amdgcn_mfma_f32_32x32x16_bf16((a), (b), (c), 0, 0, 0)
#define MFMA16(a, b, c) __builtin_amdgcn_mfma_f32_16x16x32_bf16((a), (b), (c), 0, 0, 0)
#define LDS_FENCE() asm volatile("s_waitcnt lgkmcnt(0)" ::: "memory")

struct EpiRes {
    static constexpr bool PERM = true, AFTER_DRAIN = false;
    const float* base_p; const float* base_s;
    float* out; const float* gate;
    DI void operator()(const pg8::f32x4 (&acc)[2][2][4][2], const pg8::Unit& u, int wr, int wc, int fr, int fq) const {
        const int row0 = u.pm * 256 + wr * 64 + fr; const int cnd = cond_of_row(u.pm * 256);
        const float* g = gate + cnd * 6144; const int col0 = u.pn * 256 + wc * 32 + 8 * fq;
        f32x4 gv[2][2];
#pragma unroll
        for (int bj = 0; bj < 2; ++bj)
#pragma unroll
            for (int n = 0; n < 2; ++n) gv[bj][n] = *(const f32x4*)(g + col0 + bj * 128 + n * 4);
        const float* bb = (u.pm * 256 < MP) ? base_p + (size_t)row0 * 1024 : base_s + (size_t)(row0 - MP) * 1024;
        float* oo = out + (size_t)row0 * 1024;
#pragma unroll
        for (int ai = 0; ai < 2; ++ai)
#pragma unroll
            for (int m = 0; m < 4; ++m) { const size_t ro = (size_t)(ai * 128 + m * 16) * 1024;
#pragma unroll
                for (int bj = 0; bj < 2; ++bj)
#pragma unroll
                    for (int n = 0; n < 2; ++n) { const int c = col0 + bj * 128 + n * 4; const f32x4 b = *(const f32x4*)(bb + ro + c); *(f32x4*)(oo + ro + c) = b + gv[bj][n] * acc[ai][bj][m][n]; } }
    }
};
struct EpiSwiglu {
    static constexpr bool PERM = true, AFTER_DRAIN = false;
    bf16* O;
    DI void operator()(const pg8::f32x4 (&acc)[2][2][4][2], const pg8::Unit& u, int wr, int wc, int fr, int fq) const {
        const int row0 = u.pm * 256 + wr * 64 + fr; const int hcol0 = u.pn * 128 + wc * 32 + 8 * fq;
#pragma unroll
        for (int ai = 0; ai < 2; ++ai)
#pragma unroll
            for (int m = 0; m < 4; ++m) { float v[8];
#pragma unroll
                for (int n = 0; n < 2; ++n) { const f32x4 g = acc[ai][0][m][n], up = acc[ai][1][m][n];
#pragma unroll
                    for (int e = 0; e < 4; ++e) v[4 * n + e] = g[e] * __builtin_amdgcn_rcpf(1.f + __expf(-g[e])) * up[e]; }
                u32x4 o; o.x = pk2(v[0], v[1]); o.y = pk2(v[2], v[3]); o.z = pk2(v[4], v[5]); o.w = pk2(v[6], v[7]);
                *(u32x4*)(O + (size_t)(row0 + ai * 128 + m * 16) * DFF + hcol0) = o; }
    }
};

DI int rowmap(int mode, int n) { if (mode == 0) return n; if (n < DFF) return 256 * (n >> 7) + (n & 127); n -= DFF; return 256 * (n >> 7) + 128 + (n & 127); }
DI void transpose_item(const float* W, int K, int N, bf16* WT, int row_off, int mode, LAS float* scr, int item, int lane) {
    const int nblk = N / 32, kb = item / nblk, nb = item % nblk, k0 = 64 * kb, n0 = 32 * nb;
#pragma unroll 8
    for (int i = 0; i < 32; ++i) { const int kk = 2 * i + (lane >> 5); scr[kk * 33 + (lane & 31)] = W[(size_t)(k0 + kk) * N + n0 + (lane & 31)]; }
    LDS_FENCE();
    const int c = lane & 7;
#pragma unroll
    for (int j = 0; j < 4; ++j) { const int n = (lane >> 3) + 8 * j; const LAS float* s = scr + (8 * c) * 33 + n;
        u32x4 o; o.x = pk2(s[0 * 33], s[1 * 33]); o.y = pk2(s[2 * 33], s[3 * 33]); o.z = pk2(s[4 * 33], s[5 * 33]); o.w = pk2(s[6 * 33], s[7 * 33]);
        *(u32x4*)(WT + (size_t)(row_off + rowmap(mode, n0 + n)) * K + k0 + 8 * c) = o; }
    LDS_FENCE();
}
DI void p0_convert(const Args& a, LAS unsigned char* lds, int gw, int ngw, int w, int lane) {
    LAS float* scr = (LAS float*)(lds + w * 16384);
    constexpr int I_IN = 16 * 41, I_OUT = 16 * 32, I_F1 = 16 * 176, I_F2 = 44 * 32, I_UQ = 4 * 18, I_UK = 2 * 12, I_GLU = 4 * 8;
    constexpr int PER = I_IN + I_OUT + I_F1 + I_F2 + I_UQ + 2 * I_UK + I_GLU;
    for (int it = gw; it < PER * NLAYER; it += ngw) {
        const int l = it / PER; int r = it % PER;
        if (r < I_IN) { transpose_item(a.in[14] + (size_t)l * 1024 * 1312, 1024, 1312, (bf16*)(a.ws + WS_WIN) + (size_t)l * 1536 * 1024, 0, 0, scr, r, lane); continue; } r -= I_IN;
        if (r < I_OUT) { transpose_item(a.in[32] + (size_t)l * 1024 * 1024, 1024, 1024, (bf16*)(a.ws + WS_WOUT) + (size_t)l * 1024 * 1024, 0, 0, scr, r, lane); continue; } r -= I_OUT;
        if (r < I_F1) { transpose_item(a.in[33] + (size_t)l * 1024 * 5632, 1024, 5632, (bf16*)(a.ws + WS_WF1) + (size_t)l * 5632 * 1024, 0, 1, scr, r, lane); continue; } r -= I_F1;
        if (r < I_F2) { transpose_item(a.in[34] + (size_t)l * 2816 * 1024, 2816, 1024, (bf16*)(a.ws + WS_WF2) + (size_t)l * 1024 * 2816, 0, 0, scr, r, lane); continue; } r -= I_F2;
        if (r < I_UQ) { transpose_item(a.in[19] + (size_t)l * 256 * 576, 256, 576, (bf16*)(a.ws + WS_WUQ) + (size_t)l * 576 * 256, 0, 0, scr, r, lane); continue; } r -= I_UQ;
        if (r < I_UK) { transpose_item(a.in[20] + (size_t)l * 128 * 384, 128, 384, (bf16*)(a.ws + WS_WUKV) + (size_t)l * 768 * 128, 0, 0, scr, r, lane); continue; } r -= I_UK;
        if (r < I_UK) { transpose_item(a.in[21] + (size_t)l * 128 * 384, 128, 384, (bf16*)(a.ws + WS_WUKV) + (size_t)l * 768 * 128, 384, 0, scr, r, lane); continue; } r -= I_UK;
        transpose_item(a.in[30] + (size_t)l * 256 * 256, 256, 256, (bf16*)(a.ws + WS_WGLU) + (size_t)l * 256 * 256, 0, 0, scr, r, lane);
    }
    for (int i = gw * 64 + lane; i < NLAYER * 28672; i += ngw * 64) { const int l = i / 28672, r = i % 28672;
        *(u32x4*)((bf16*)(a.ws + WS_WIN) + ((size_t)l * 1536 + 1312) * 1024 + (size_t)r * 8) = (u32x4){0u, 0u, 0u, 0u}; }
}
DI void ada_partial_item(const Args& a, LAS unsigned char* lds, int it, int tid) {
    const int l = it / 192, r = it % 192, cb = r >> 3, ks = r & 7;
    LAS float* s = (LAS float*)lds;
    LAS float* red = (LAS float*)(lds + 8192);
    const float* c_in = a.in[8]; const float* c_ctx = a.in[9];
    for (int i = tid; i < 9 * 128; i += 512) { const int c = i >> 7, k = i & 127, kk = ks * 128 + k; const float x = c == 0 ? c_ctx[kk] : c_in[(c - 1) * 1024 + kk]; s[i] = x / (1.f + expf(-x)); }
    __syncthreads();
    const int col = cb * 256 + (tid & 255), half = tid >> 8;
    const float* W = a.in[12] + ((size_t)l * 1024 + ks * 128 + half * 64) * 6144 + col;
    float acc[9];
#pragma unroll
    for (int c = 0; c < 9; ++c) acc[c] = 0.f;
#pragma unroll 4
    for (int k = 0; k < 64; ++k) { const float wv = W[(size_t)k * 6144];
#pragma unroll
        for (int c = 0; c < 9; ++c) acc[c] = fmaf(s[c * 128 + half * 64 + k], wv, acc[c]); }
    if (half == 1) {
#pragma unroll
        for (int c = 0; c < 9; ++c) red[c * 256 + (tid & 255)] = acc[c]; }
    __syncthreads();
    if (half == 0) { float* P = (float*)(a.ws + WS_MODP) + ((size_t)(l * 8 + ks) * 9) * 6144;
#pragma unroll
        for (int c = 0; c < 9; ++c) P[(size_t)c * 6144 + col] = acc[c] + red[c * 256 + tid]; }
    __syncthreads();
}

DI void norm_rows(const float* xp, const float* xs, const float* g, const float* mod_l, int sh_off, int sc_off, bf16* H, int gw, int ngw, int lane) {
    for (int m = gw; m < MT; m += ngw) {
        const float* xr = (m < MP) ? xp + (size_t)m * 1024 : xs + (size_t)(m - MP) * 1024;
        f32x4 v[4]; float ss = 0.f;
#pragma unroll
        for (int j = 0; j < 4; ++j) { v[j] = ((const f32x4*)xr)[lane + 64 * j]; ss += (v[j].x * v[j].x + v[j].y * v[j].y) + (v[j].z * v[j].z + v[j].w * v[j].w); }
        const float rstd = rsq(wave_sum(ss) * (1.f / 1024.f) + EPS);
        const float* md = mod_l + cond_of_row(m) * 6144;
        u32x2* o8 = (u32x2*)(H + (size_t)m * 1024);
#pragma unroll
        for (int j = 0; j < 4; ++j) { const int idx = 4 * (lane + 64 * j);
            const f32x4 gg = *(const f32x4*)(g + idx), sc = *(const f32x4*)(md + sc_off + idx), sh = *(const f32x4*)(md + sh_off + idx);
            const f32x4 o = v[j] * rstd * gg * (sc + 1.0f) + sh; u32x2 pk; pk.x = pk2(o.x, o.y); pk.y = pk2(o.z, o.w); o8[lane + 64 * j] = pk; }
    }
}
DI void final_norm_rows(float* X, const float* g, int gw, int ngw, int lane) {
    for (int m = gw; m < MT; m += ngw) {
        f32x4* xr = (f32x4*)(X + (size_t)m * 1024);
        f32x4 v[4]; float ss = 0.f;
#pragma unroll
        for (int j = 0; j < 4; ++j) { v[j] = xr[lane + 64 * j]; ss += (v[j].x * v[j].x + v[j].y * v[j].y) + (v[j].z * v[j].z + v[j].w * v[j].w); }
        const float rstd = rsq(wave_sum(ss) * (1.f / 1024.f) + EPS);
#pragma unroll
        for (int j = 0; j < 4; ++j) { const f32x4 gg = *(const f32x4*)(g + 4 * (lane + 64 * j)); xr[lane + 64 * j] = v[j] * rstd * gg; }
    }
}


template <int NB, int NK, int PA, int KW>
DI void small_gemm(const LAS bf16* A, const bf16* W, int krot, f32x4 (&acc)[NB][2], int n16, int kq) {
    bf16x8 bb[2][NB];
    { const int ks = krot & (NK - 1);
#pragma unroll
      for (int c = 0; c < NB; ++c) bb[0][c] = *(const bf16x8*)(W + (size_t)c * 16 * KW + ks * 32); }
#pragma unroll
    for (int i = 0; i < NK; ++i) { const int cur = i & 1, ks = (i + krot) & (NK - 1);
        if (i + 1 < NK) { const int kn = (i + 1 + krot) & (NK - 1);
#pragma unroll
            for (int c = 0; c < NB; ++c) bb[cur ^ 1][c] = *(const bf16x8*)(W + (size_t)c * 16 * KW + kn * 32); }
        const bf16x8 a0 = *(const LAS bf16x8*)(A + n16 * PA + ks * 32 + 8 * kq), a1 = *(const LAS bf16x8*)(A + (16 + n16) * PA + ks * 32 + 8 * kq);
        __builtin_amdgcn_sched_barrier(0);
#pragma unroll
        for (int c = 0; c < NB; ++c) { acc[c][0] = MFMA16(a0, bb[cur][c], acc[c][0]); acc[c][1] = MFMA16(a1, bb[cur][c], acc[c][1]); }
        __builtin_amdgcn_sched_barrier(0);
    }
}

constexpr int L2_TAB = 0;
constexpr int L2_ACQ = 12288;
constexpr int L2_ACKV = L2_ACQ + 16896;
constexpr int L2_QBS = L2_ACKV + 8704;
constexpr int L2_KBS = L2_QBS + 36864;
constexpr int L2_VTBS = L2_KBS + 36864;
constexpr int L2_VTAS = L2_VTBS + 24576;
static_assert(L2_VTAS + 8192 <= LDS_BYTES, "L2 LDS");
DI size_t vtbase(int seq, int C) { return seq < 16 ? (size_t)seq * C * 256 : (size_t)16 * C * 256 + (size_t)(seq - 16) * C * LKS; }

DI void post_tables(LAS unsigned char* lds, int tid) {
    LAS float* c16 = (LAS float*)(lds + L2_TAB); LAS float* s16 = c16 + 1024; LAS float* c8 = c16 + 2048; LAS float* s8 = c16 + 2560;
    for (int i = tid; i < 1024; i += 512) { const int p = i >> 4, f = i & 15; const float inv = exp2f(-(float)f * (13.287712379549449f / 16.f)); float s, c; sincos_acc((float)p * inv, s, c); c16[i] = c; s16[i] = s; }
    for (int i = tid; i < 512; i += 512) { const int p = i >> 3, f = i & 7; const float inv = exp2f(-(float)f * (13.287712379549449f / 8.f)); float s, c; sincos_acc((float)p * inv, s, c); c8[i] = c; s8[i] = s; }
}

template <int PABL>
DI void post_item(const Args& a, LAS unsigned char* lds, int l, int item, int tid, int lane, int w) {
    const bool is_cache = item >= 1152;
    int m0 = 0, seq, t0, krow0; bool sample;
    if (!is_cache) { m0 = item * 32;
        if (m0 < MP) { seq = m0 >> 8; t0 = m0 & 255; sample = false; krow0 = m0; }
        else { const int r = m0 - MP; seq = 16 + (r >> 12); t0 = r & 4095; sample = true; krow0 = MP + (seq - 16) * LKS + t0; } }
    else { const int j = item - 1152, b = j >> 4; seq = 16 + b; t0 = NSL + (j & 15) * 32; sample = true; krow0 = MP + b * LKS + t0; }
    const int Lk = seq < 16 ? 256 : LKS;
    const LAS float* c16 = (const LAS float*)(lds + L2_TAB); const LAS float* s16 = c16 + 1024; const LAS float* c8 = c16 + 2048; const LAS float* s8 = c16 + 2560;
    LAS bf16* ACQ = (LAS bf16*)(lds + L2_ACQ); LAS bf16* ACKV = (LAS bf16*)(lds + L2_ACKV);
    LAS bf16* QBS = (LAS bf16*)(lds + L2_QBS); LAS bf16* KBS = (LAS bf16*)(lds + L2_KBS);
    LAS bf16* VTBS = (LAS bf16*)(lds + L2_VTBS); LAS bf16* VTAS = (LAS bf16*)(lds + L2_VTAS);
    bf16* QA = (bf16*)(a.ws + WS_QA); bf16* QB = (bf16*)(a.ws + WS_QB); bf16* KA = (bf16*)(a.ws + WS_KA); bf16* KB = (bf16*)(a.ws + WS_KB);
    bf16* VTA = (bf16*)(a.ws + WS_VTA); bf16* VTB = (bf16*)(a.ws + WS_VTB); bf16* UU = (bf16*)(a.ws + WS_UU);
    const bf16* PROJ = (const bf16*)(a.ws + WS_PROJ);
    if (PABL & 1) {} else
    if (!is_cache) {
        const int hd = lane >> 3, sub = lane & 7;
        const float* nw = (hd < 6) ? a.in[15] + l * 64 : a.in[16] + l * 64;
        const f32x4 nw0 = *(const f32x4*)(nw + 4 * sub), nw1 = *(const f32x4*)(nw + 32 + 4 * sub);
        const int e2 = (lane < 16) ? 512 + 8 * lane : (lane < 48) ? 640 + 8 * (lane - 16) : 896 + 8 * (lane - 48);
        const float* n2p = (lane < 48) ? a.in[17] + l * 256 + 8 * ((lane - 16) & 31) : a.in[18] + l * 128 + 8 * (lane - 48);
        const f32x4 n20 = *(const f32x4*)n2p, n21 = *(const f32x4*)(n2p + 4);
        u32x2 qa0[4], qa1[4]; u32x4 ld2[4]; u32x2 kr0[4], kr1[4]; u32x4 ldu[4];
#pragma unroll
        for (int rr = 0; rr < 4; ++rr) { const bf16* pr = PROJ + (size_t)(m0 + 4 * w + rr) * NINP;
            qa0[rr] = *(const u32x2*)(pr + hd * 64 + 4 * sub); qa1[rr] = *(const u32x2*)(pr + hd * 64 + 32 + 4 * sub);
            ld2[rr] = *(const u32x4*)(pr + e2);
            if (lane < 4) { kr0[rr] = *(const u32x2*)(pr + 1024 + 4 * lane); kr1[rr] = *(const u32x2*)(pr + 1040 + 4 * lane); }
            else if (lane < 36) ldu[rr] = *(const u32x4*)(pr + 1056 + 8 * (lane - 4)); }
#pragma unroll
        for (int rr = 0; rr < 4; ++rr) {
            const int r = 4 * w + rr, m = m0 + r, t = t0 + r, trow = t >> 6, tcol = t & 63;
            const size_t orow = (size_t)((seq * 4 + l) * 256 + t);
            { float x0[4] = {bflo(qa0[rr].x), bfhi(qa0[rr].x), bflo(qa0[rr].y), bfhi(qa0[rr].y)}, x1[4] = {bflo(qa1[rr].x), bfhi(qa1[rr].x), bflo(qa1[rr].y), bfhi(qa1[rr].y)};
              float ss = (x0[0] * x0[0] + x0[1] * x0[1]) + (x0[2] * x0[2] + x0[3] * x0[3]) + (x1[0] * x1[0] + x1[1] * x1[1]) + (x1[2] * x1[2] + x1[3] * x1[3]);
              ss += __shfl_xor(ss, 1); ss += __shfl_xor(ss, 2); ss += __shfl_xor(ss, 4);
              const float rs = rsq(ss * (1.f / 64.f) + EPS);
#pragma unroll
              for (int e = 0; e < 4; ++e) { x0[e] *= rs * nw0[e]; x1[e] *= rs * nw1[e]; }
              if (hd >= 6 && !sample) { float* ok = a.out + O_K + (orow * 2 + (hd - 6)) * 64; *(f32x4*)(ok + 4 * sub) = (f32x4){x0[0], x0[1], x0[2], x0[3]}; *(f32x4*)(ok + 32 + 4 * sub) = (f32x4){x1[0], x1[1], x1[2], x1[3]}; }
              if (sample) { const int p16 = (sub < 4) ? trow : tcol; const f32x4 cs = *(const LAS f32x4*)(c16 + p16 * 16 + 4 * (sub & 3)), sn = *(const LAS f32x4*)(s16 + p16 * 16 + 4 * (sub & 3));
#pragma unroll
                  for (int e = 0; e < 4; ++e) { const float a1 = x0[e], a2 = x1[e]; x0[e] = a1 * cs[e] - a2 * sn[e]; x1[e] = a1 * sn[e] + a2 * cs[e]; } }
              const float sc = (hd < 6) ? QSC_A : 1.f;
              u32x2 o0, o1; o0.x = pk2(x0[0] * sc, x0[1] * sc); o0.y = pk2(x0[2] * sc, x0[3] * sc); o1.x = pk2(x1[0] * sc, x1[1] * sc); o1.y = pk2(x1[2] * sc, x1[3] * sc);
              bf16* dst = (hd < 6) ? QA + (size_t)m * 384 + hd * 64 : KA + (size_t)(krow0 + r) * 128 + (hd - 6) * 64;
              *(u32x2*)(dst + 4 * sub) = o0; *(u32x2*)(dst + 32 + 4 * sub) = o1; }
            { float x[8] = {bflo(ld2[rr].x), bfhi(ld2[rr].x), bflo(ld2[rr].y), bfhi(ld2[rr].y), bflo(ld2[rr].z), bfhi(ld2[rr].z), bflo(ld2[rr].w), bfhi(ld2[rr].w)};
              float ss = (x[0] * x[0] + x[1] * x[1]) + (x[2] * x[2] + x[3] * x[3]) + (x[4] * x[4] + x[5] * x[5]) + (x[6] * x[6] + x[7] * x[7]);
              ss += __shfl_xor(ss, 1); ss += __shfl_xor(ss, 2); ss += __shfl_xor(ss, 4); ss += __shfl_xor(ss, 8);
              const float scq = __int_as_float(__builtin_amdgcn_readlane(__float_as_int(ss), 16)) + __int_as_float(__builtin_amdgcn_readlane(__float_as_int(ss), 32));
              const float skv = __int_as_float(__builtin_amdgcn_readlane(__float_as_int(ss), 48));
              if (lane < 16) {
                  if (!sample) { float* ov = a.out + O_V + orow * 128 + 8 * lane; *(f32x4*)ov = (f32x4){x[0], x[1], x[2], x[3]}; *(f32x4*)(ov + 4) = (f32x4){x[4], x[5], x[6], x[7]}; }
#pragma unroll
                  for (int e = 0; e < 8; ++e) VTAS[(8 * lane + e) * 32 + swap23(r)] = f2bf(x[e]);
              } else if (lane < 48) {
                  const float rs = rsq(scq * (1.f / 256.f) + EPS);
                  u32x4 o; o.x = pk2(x[0] * rs * n20.x, x[1] * rs * n20.y); o.y = pk2(x[2] * rs * n20.z, x[3] * rs * n20.w); o.z = pk2(x[4] * rs * n21.x, x[5] * rs * n21.y); o.w = pk2(x[6] * rs * n21.z, x[7] * rs * n21.w);
                  *(LAS u32x4*)(ACQ + r * 264 + 8 * (lane - 16)) = o;
              } else {
                  const float rs = rsq(skv * (1.f / 128.f) + EPS);
                  const float y0 = x[0] * rs * n20.x, y1 = x[1] * rs * n20.y, y2 = x[2] * rs * n20.z, y3 = x[3] * rs * n20.w, y4 = x[4] * rs * n21.x, y5 = x[5] * rs * n21.y, y6 = x[6] * rs * n21.z, y7 = x[7] * rs * n21.w;
                  if (!sample) { float* oc = a.out + O_CKV + orow * 128 + 8 * (lane - 48); *(f32x4*)oc = (f32x4){y0, y1, y2, y3}; *(f32x4*)(oc + 4) = (f32x4){y4, y5, y6, y7}; }
                  u32x4 o; o.x = pk2(y0, y1); o.y = pk2(y2, y3); o.z = pk2(y4, y5); o.w = pk2(y6, y7);
                  *(LAS u32x4*)(ACKV + r * 136 + 8 * (lane - 48)) = o;
              } }
            if (lane < 4) {
                float x0[4] = {bflo(kr0[rr].x), bfhi(kr0[rr].x), bflo(kr0[rr].y), bfhi(kr0[rr].y)}, x1[4] = {bflo(kr1[rr].x), bfhi(kr1[rr].x), bflo(kr1[rr].y), bfhi(kr1[rr].y)};
                if (!sample) { float* ok = a.out + O_KR + orow * 32; *(f32x4*)(ok + 4 * lane) = (f32x4){x0[0], x0[1], x0[2], x0[3]}; *(f32x4*)(ok + 16 + 4 * lane) = (f32x4){x1[0], x1[1], x1[2], x1[3]}; }
                else { const int p8 = (lane < 2) ? trow : tcol; const f32x4 cs = *(const LAS f32x4*)(c8 + p8 * 8 + 4 * (lane & 1)), sn = *(const LAS f32x4*)(s8 + p8 * 8 + 4 * (lane & 1));
#pragma unroll
                    for (int e = 0; e < 4; ++e) { const float a1 = x0[e], a2 = x1[e]; x0[e] = a1 * cs[e] - a2 * sn[e]; x1[e] = a1 * sn[e] + a2 * cs[e]; } }
                u32x2 o0, o1; o0.x = pk2(x0[0], x0[1]); o0.y = pk2(x0[2], x0[3]); o1.x = pk2(x1[0], x1[1]); o1.y = pk2(x1[2], x1[3]);
#pragma unroll
                for (int h = 0; h < 6; ++h) { *(LAS u32x2*)(KBS + r * 576 + h * 96 + 64 + 4 * lane) = o0; *(LAS u32x2*)(KBS + r * 576 + h * 96 + 80 + 4 * lane) = o1; }
            } else if (lane < 36) *(u32x4*)(UU + (size_t)m * 256 + 8 * (lane - 4)) = ldu[rr];
        }
    } else {
        const int b = seq - 16;
#pragma unroll 1
        for (int rr = 0; rr < 4; ++rr) {
            const int r = 4 * w + rr, p = (t0 - NSL) + r;
            const size_t cb = (size_t)(b * 4 + l) * 512 + p;
            const float* ck = a.in[2] + cb * 128; const float* cv = a.in[3] + cb * 128; const float* cc = a.in[4] + cb * 128; const float* ckr = a.in[5] + cb * 32;
            KA[(size_t)(krow0 + r) * 128 + lane] = f2bf(ck[lane]); KA[(size_t)(krow0 + r) * 128 + 64 + lane] = f2bf(ck[64 + lane]);
            VTAS[lane * 32 + swap23(r)] = f2bf(cv[lane]); VTAS[(64 + lane) * 32 + swap23(r)] = f2bf(cv[64 + lane]);
            { const f32x2 v = *(const f32x2*)(cc + lane * 2); *(LAS unsigned*)(ACKV + r * 136 + lane * 2) = pk2(v.x, v.y); }
            if (lane < 32) { const unsigned short bb = f2bf(ckr[lane]);
#pragma unroll
                for (int h = 0; h < 6; ++h) KBS[r * 576 + h * 96 + 64 + lane] = bb; }
        }
    }
    __syncthreads();
    const int n16 = lane & 15, kq = lane >> 4;
    if (!(PABL & 2)) {
    if (!is_cache && w < 6) {
        const bf16* W = (const bf16*)(a.ws + WS_WUQ) + (size_t)l * 576 * 256 + (size_t)(w * 96 + n16) * 256 + 8 * kq;
        f32x4 acc[6][2];
#pragma unroll
        for (int c = 0; c < 6; ++c) { acc[c][0] = (f32x4){0.f, 0.f, 0.f, 0.f}; acc[c][1] = (f32x4){0.f, 0.f, 0.f, 0.f}; }
        small_gemm<6, 8, 264, 256>(ACQ, W, item * 3 + w, acc, n16, kq);
#pragma unroll
        for (int rb = 0; rb < 2; ++rb)
#pragma unroll
            for (int i = 0; i < 4; ++i) { const int row = 16 * rb + 4 * kq + i;
                if (sample) { const int t = t0 + row, p8 = (n16 < 8) ? (t >> 6) : (t & 63); const float c = c8[p8 * 8 + (n16 & 7)], s = s8[p8 * 8 + (n16 & 7)];
                    const float x1 = acc[4][rb][i], x2 = acc[5][rb][i]; acc[4][rb][i] = x1 * c - x2 * s; acc[5][rb][i] = x1 * s + x2 * c; }
#pragma unroll
                for (int c = 0; c < 6; ++c) QBS[row * 576 + w * 96 + c * 16 + n16] = f2bf(acc[c][rb][i] * QSC_B); }
    }
    {
        const bf16* W = (const bf16*)(a.ws + WS_WUKV) + (size_t)l * 768 * 128 + (size_t)(w * 96 + n16) * 128 + 8 * kq;
        f32x4 acc[6][2];
#pragma unroll
        for (int c = 0; c < 6; ++c) { acc[c][0] = (f32x4){0.f, 0.f, 0.f, 0.f}; acc[c][1] = (f32x4){0.f, 0.f, 0.f, 0.f}; }
        small_gemm<6, 4, 136, 128>(ACKV, W, item * 3 + w, acc, n16, kq);
#pragma unroll
        for (int c = 0; c < 6; ++c) { const int cb = w * 6 + c;
#pragma unroll
            for (int rb = 0; rb < 2; ++rb)
#pragma unroll
                for (int i = 0; i < 4; ++i) { const int row = 16 * rb + 4 * kq + i; const unsigned short v = f2bf(acc[c][rb][i]);
                    if (w < 4) KBS[row * 576 + (cb >> 2) * 96 + (cb & 3) * 16 + n16] = v;
                    else { const int cb2 = cb - 24; VTBS[((cb2 >> 2) * 64 + (cb2 & 3) * 16 + n16) * 32 + swap23(row)] = v; } } }
    }
    }
    __syncthreads();
    if (!(PABL & 4)) {
    if (!is_cache) for (int i = tid; i < 2304; i += 512) *(u32x4*)(QB + (size_t)m0 * 576 + (size_t)i * 8) = *(const LAS u32x4*)(QBS + i * 8);
    for (int i = tid; i < 2304; i += 512) *(u32x4*)(KB + (size_t)krow0 * 576 + (size_t)i * 8) = *(const LAS u32x4*)(KBS + i * 8);
    { bf16* dst = VTB + vtbase(seq, 384) + t0;
      for (int i = tid; i < 1536; i += 512) { const int d = i >> 2, ch = i & 3; *(u32x4*)(dst + (size_t)d * Lk + ch * 8) = *(const LAS u32x4*)(VTBS + d * 32 + ch * 8); } }
    { bf16* dst = VTA + vtbase(seq, 128) + t0; const int d = tid >> 2, ch = tid & 3; *(u32x4*)(dst + (size_t)d * Lk + ch * 8) = *(const LAS u32x4*)(VTAS + d * 32 + ch * 8); }
    }
    __syncthreads();
}

DI float max3f(float a, float b, float c) { float r; asm("v_max3_f32 %0, %1, %2, %3" : "=v"(r) : "v"(a), "v"(b), "v"(c)); return r; }
#define SBAR() __builtin_amdgcn_sched_barrier(0)
template <int DQK, bool HN, int ABL>
DI void att_step(f32x16& C0, f32x16& C1, f32x16& N0, f32x16& N1, f32x16& o0, f32x16& o1, f32x16& negm, float& mref, float& lsum,
                 const bf16x8 (&qf)[DQK / 16], const LAS unsigned char* kb, const LAS unsigned char* vb) {
    constexpr int ND = DQK / 16, NQ = 2 * ND, KP = DQK * 2 + 16, VP = 144, NI = NQ > 8 ? NQ : 8;
    constexpr int AH = 4;
    bf16x8 kf[NQ];
    if (HN) {
#pragma unroll
        for (int i = 0; i < AH; ++i) kf[i] = *(const LAS bf16x8*)(kb + (i & 1) * 32 * KP + (i >> 1) * 32);
    }
    SBAR();
    u32x4 pw[4];
#pragma unroll
    for (int i = 0; i < NI; ++i) {
        if (HN && i < NQ) { if (i & 1) N1 = MFMA32(kf[i], qf[i >> 1], (i < 2) ? negm : N1); else N0 = MFMA32(kf[i], qf[i >> 1], (i < 2) ? negm : N0); }
        if (HN && i + AH < NQ) kf[i + AH] = *(const LAS bf16x8*)(kb + ((i + AH) & 1) * 32 * KP + ((i + AH) >> 1) * 32);
        if (i < 8) {
#pragma unroll
            for (int e = 0; e < 4; ++e) { const int idx = 4 * (i & 3) + e; if (ABL & 1) { if (i < 4) C0[idx] = fmaf(C0[idx], 0.001f, 1.f); else C1[idx] = fmaf(C1[idx], 0.001f, 1.f); } else { if (i < 4) C0[idx] = __builtin_amdgcn_exp2f(C0[idx]); else C1[idx] = __builtin_amdgcn_exp2f(C1[idx]); } }
            if (i & 1) { const int k = i >> 1, b8 = 8 * (k & 1);
                if (k < 2) { pw[k].x = pk2(C0[b8], C0[b8 + 1]); pw[k].y = pk2(C0[b8 + 2], C0[b8 + 3]); pw[k].z = pk2(C0[b8 + 4], C0[b8 + 5]); pw[k].w = pk2(C0[b8 + 6], C0[b8 + 7]); }
                else { pw[k].x = pk2(C1[b8], C1[b8 + 1]); pw[k].y = pk2(C1[b8 + 2], C1[b8 + 3]); pw[k].z = pk2(C1[b8 + 4], C1[b8 + 5]); pw[k].w = pk2(C1[b8 + 6], C1[b8 + 7]); } }
        }
        SBAR();
    }
    bf16x8 vf[8];
#pragma unroll
    for (int i = 0; i < AH; ++i) vf[i] = *(const LAS bf16x8*)(vb + (i & 1) * 32 * VP + (i >> 1) * 32);
    SBAR();
    float ps = 0.f, mx = -3.0e38f;
#pragma unroll
    for (int i = 0; i < 8; ++i) {
        if (i & 1) o1 = MFMA32(vf[i], __builtin_bit_cast(bf16x8, pw[i >> 1]), o1); else o0 = MFMA32(vf[i], __builtin_bit_cast(bf16x8, pw[i >> 1]), o0);
        if (i + AH < 8) vf[i + AH] = *(const LAS bf16x8*)(vb + ((i + AH) & 1) * 32 * VP + ((i + AH) >> 1) * 32);
        if (HN && i == 0) asm volatile("s_nop 11" : "+v"(N0), "+v"(N1));
#pragma unroll
        for (int e = 0; e < 4; ++e) { const int idx = 4 * (i & 3) + e; ps += (i < 4) ? C0[idx] : C1[idx]; }
        if (HN && !(ABL & 8)) { mx = max3f(mx, N0[2 * i], N1[2 * i]); mx = max3f(mx, N0[2 * i + 1], N1[2 * i + 1]); }
        SBAR();
    }
    lsum += ps;
    if (HN && !(ABL & 8)) {
        { auto rr = __builtin_amdgcn_permlane32_swap(__float_as_uint(mx), __float_as_uint(mx), false, false); mx = fmaxf(__uint_as_float(rr[0]), __uint_as_float(rr[1])); }
        if (__any(mx > 8.f)) { const float dl = fmaxf(mx, 0.f); mref += dl; const float f = __builtin_amdgcn_exp2f(-dl);
#pragma unroll
            for (int i = 0; i < 16; ++i) { N0[i] -= dl; N1[i] -= dl; negm[i] = -mref; o0[i] *= f; o1[i] *= f; }
            lsum *= f; }
    }
}

template <int DQK, int ABL>
DI void attn_unit(LAS unsigned char* lds, const bf16* Q, int qpitch, const bf16* K, int kpitch, const bf16* VT, int Lk, bf16* O, int tid_in) {
    constexpr int ND = DQK / 16, NQ = 2 * ND, KP = DQK * 2 + 16, VP = 144, NCH = DQK / 8, KBUF = 64 * KP, VBUF = 64 * VP;
    LAS unsigned char* Kl = lds; LAS unsigned char* Vl = lds + 2 * KBUF;
    int tid = tid_in; asm volatile("" : "+v"(tid));
    const int lane = tid & 63, w = __builtin_amdgcn_readfirstlane(tid >> 6);
    const int r = lane & 31, hh = lane >> 5;
    const int kr0 = tid / NCH, kc0 = tid % NCH, kr1 = (tid + 512) / NCH, kc1 = (tid + 512) % NCH;
    const bool k2 = (DQK == 96) && (tid < 256);
    const int vd = tid >> 3, vc = tid & 7;
    u32x4 kreg0, kreg1 = (u32x4){0u, 0u, 0u, 0u}, vreg;
#define ATT_LOADK(tile) do { if (ABL & 2) break; kreg0 = *(const u32x4*)(K + (size_t)((tile) * 64 + kr0) * kpitch + kc0 * 8); \
        if (k2) kreg1 = *(const u32x4*)(K + (size_t)((tile) * 64 + kr1) * kpitch + kc1 * 8); } while (0)
#define ATT_LOADV(tile) do { if (ABL & 2) break; vreg = *(const u32x4*)(VT + (size_t)vd * Lk + (tile) * 64 + vc * 8); } while (0)
#define ATT_STOREK(buf) do { if (ABL & 2) break; *(LAS u32x4*)(Kl + (buf) * KBUF + kr0 * KP + kc0 * 16) = kreg0; \
        if (k2) *(LAS u32x4*)(Kl + (buf) * KBUF + kr1 * KP + kc1 * 16) = kreg1; } while (0)
#define ATT_STOREV(buf) do { if (ABL & 2) break; *(LAS u32x4*)(Vl + (buf) * VBUF + vd * VP + vc * 16) = vreg; } while (0)
    bf16x8 qf[ND];
#pragma unroll
    for (int d0 = 0; d0 < ND; ++d0) qf[d0] = *(const bf16x8*)(Q + (size_t)(w * 32 + r) * qpitch + d0 * 16 + hh * 8);
    const int NT = Lk >> 6;
    ATT_LOADK(0); ATT_STOREK(0); ATT_LOADV(0); ATT_STOREV(0); ATT_LOADK(1); ATT_STOREK(1);
    __syncthreads();
    const LAS unsigned char* kbase = Kl + r * KP + hh * 16;
    const LAS unsigned char* vbase = Vl + r * VP + hh * 16;
    f32x16 A0, A1, B0, B1, o0, o1, negm;
#pragma unroll
    for (int i = 0; i < 16; ++i) { A0[i] = 0.f; A1[i] = 0.f; B0[i] = 0.f; B1[i] = 0.f; o0[i] = 0.f; o1[i] = 0.f; }
    {
        bf16x8 kf[NQ];
#pragma unroll
        for (int i = 0; i < NQ; ++i) kf[i] = *(const LAS bf16x8*)(kbase + (i & 1) * 32 * KP + (i >> 1) * 32);
#pragma unroll
        for (int i = 0; i < NQ; ++i) { if (i & 1) A1 = MFMA32(kf[i], qf[i >> 1], A1); else A0 = MFMA32(kf[i], qf[i >> 1], A0); }
    }
    float mref = fmaxf(A0[0], A1[0]);
#pragma unroll
    for (int i = 1; i < 16; ++i) mref = fmaxf(mref, fmaxf(A0[i], A1[i]));
    mref = fmaxf(mref, __shfl_xor(mref, 32));
#pragma unroll
    for (int i = 0; i < 16; ++i) { A0[i] -= mref; A1[i] -= mref; negm[i] = -mref; }
    float lsum = 0.f;
#pragma unroll 1
    for (int t = 0; t + 2 < NT; t += 2) {
        ATT_LOADK(t + 2); ATT_LOADV(t + 1);
        att_step<DQK, true, ABL>(A0, A1, B0, B1, o0, o1, negm, mref, lsum, qf, kbase + KBUF, vbase);
        ATT_STOREK(0); ATT_STOREV(1); if (!(ABL & 4)) __syncthreads();
        ATT_LOADK(t + 3); ATT_LOADV(t + 2);
        att_step<DQK, true, ABL>(B0, B1, A0, A1, o0, o1, negm, mref, lsum, qf, kbase, vbase + VBUF);
        ATT_STOREK(1); ATT_STOREV(0); if (!(ABL & 4)) __syncthreads();
    }
    ATT_LOADV(NT - 1);
    att_step<DQK, true, ABL>(A0, A1, B0, B1, o0, o1, negm, mref, lsum, qf, kbase + KBUF, vbase);
    ATT_STOREV(1); __syncthreads();
    att_step<DQK, false, ABL>(B0, B1, A0, A1, o0, o1, negm, mref, lsum, qf, kbase, vbase + VBUF);
    __syncthreads();
#undef ATT_LOADK
#undef ATT_LOADV
#undef ATT_STOREK
#undef ATT_STOREV
    lsum += __shfl_xor(lsum, 32);
    const float inv = 1.f / lsum;
    bf16* op = O + (size_t)(w * 32 + r) * 1024;
    if (!(ABL & 16) || lsum == 1.2345e-30f)
#pragma unroll
    for (int g4 = 0; g4 < 4; ++g4) { const int d = 8 * g4 + 4 * hh; u32x2 x0, x1;
        x0.x = pk2(o0[4 * g4] * inv, o0[4 * g4 + 1] * inv); x0.y = pk2(o0[4 * g4 + 2] * inv, o0[4 * g4 + 3] * inv);
        x1.x = pk2(o1[4 * g4] * inv, o1[4 * g4 + 1] * inv); x1.y = pk2(o1[4 * g4 + 2] * inv, o1[4 * g4 + 3] * inv);
        *(u32x2*)(op + d) = x0; *(u32x2*)(op + 32 + d) = x1; }
}

template <bool WY>
DI void s5_run(LAS float* wl, const bf16* U, float* Y, int L, int dir, int c_lo, int c_hi, const bf16x8 (&bfr)[4], const bf16x8 (&cfr)[4], float ar, float ai, float& sre, float& sim, int lane) {
    const int pl = lane & 31, hh = lane >> 5, n16 = lane & 15, kq = lane >> 4;
    f32x16 zero16;
#pragma unroll
    for (int i = 0; i < 16; ++i) zero16[i] = 0.f;
    bf16x8 uf_n0, uf_n1;
    { const int t0 = dir ? (L - 1 - c_lo - pl) : (c_lo + pl); uf_n0 = *(const bf16x8*)(U + (size_t)t0 * 256 + 8 * hh);
      const int t1 = dir ? (L - 1 - c_lo - 32 - pl) : (c_lo + 32 + pl); uf_n1 = *(const bf16x8*)(U + (size_t)t1 * 256 + 8 * hh); }
#pragma unroll 1
    for (int c0 = c_lo; c0 < c_hi; c0 += 32) {
        const bf16x8 uf = uf_n0; uf_n0 = uf_n1;
        if (c0 + 64 < c_hi) { const int t2 = dir ? (L - 1 - c0 - 64 - pl) : (c0 + 64 + pl); uf_n1 = *(const bf16x8*)(U + (size_t)t2 * 256 + 8 * hh); }
#pragma unroll
        for (int blk = 0; blk < 4; ++blk) { const f32x16 d = MFMA32(uf, bfr[blk], zero16);
#pragma unroll
            for (int i = 0; i < 16; ++i) wl[crow(i, hh) * 132 + blk * 32 + pl] = d[i]; }
        LDS_FENCE();
        {
            float br_[32], bi_[32];
#pragma unroll
            for (int tau = 0; tau < 32; ++tau) { br_[tau] = wl[tau * 132 + lane]; bi_[tau] = wl[tau * 132 + 64 + lane]; }
#pragma unroll
            for (int tau = 0; tau < 32; ++tau) { const float n_r = fmaf(ar, sre, fmaf(-ai, sim, br_[tau])), n_i = fmaf(ar, sim, fmaf(ai, sre, bi_[tau])); sre = n_r; sim = n_i; br_[tau] = n_r; bi_[tau] = n_i; }
            if (WY) {
#pragma unroll
                for (int tau = 0; tau < 32; ++tau) { wl[tau * 132 + lane] = br_[tau]; wl[tau * 132 + 64 + lane] = bi_[tau]; } }
        }
        LDS_FENCE();
        if (WY) {
#pragma unroll
            for (int rb = 0; rb < 2; ++rb) { f32x4 acc = (f32x4){0.f, 0.f, 0.f, 0.f};
#pragma unroll
                for (int ks = 0; ks < 4; ++ks) { const LAS float* sp = wl + (rb * 16 + n16) * 132 + 32 * ks + 8 * kq; const f32x4 s0 = *(const LAS f32x4*)sp, s1 = *(const LAS f32x4*)(sp + 4);
                    u32x4 pw; pw.x = pk2(s0.x, s0.y); pw.y = pk2(s0.z, s0.w); pw.z = pk2(s1.x, s1.y); pw.w = pk2(s1.z, s1.w);
                    acc = MFMA16(__builtin_bit_cast(bf16x8, pw), cfr[ks], acc); }
#pragma unroll
                for (int i = 0; i < 4; ++i) { const int tau = rb * 16 + 4 * kq + i; const int tt = dir ? (L - 1 - c0 - tau) : (c0 + tau); Y[(size_t)tt * 256 + n16] = acc[i]; } }
            LDS_FENCE();
        }
    }
}
template <bool SPLIT>
DI void s5_task(const Args& a, LAS float* wl, LAS float* xl, int l, int seq, int g, int dir, int lane, int w) {
    const int L = seq < 16 ? 256 : 4096; const int mbase = seq < 16 ? seq * 256 : MP + (seq - 16) * 4096;
    const int pidx = (l * 2 + dir) * 16 + g;
    const float lre = a.in[22][pidx * 64 + lane], lim = a.in[23][pidx * 64 + lane], dt = expf(a.in[24][pidx]);
    const float x = lre * dt, y = lim * dt, ex = expf(x); float sy, cy; sincos_acc(y, sy, cy);
    const float ar = ex * cy, ai = ex * sy;
    float shh, chh; sincos_acc(0.5f * y, shh, chh);
    const float nr = expm1_acc(x) * cy - 2.f * shh * shh, ni = ex * sy, den = lre * lre + lim * lim;
    const float cre = (nr * lre + ni * lim) / den, cim = (ni * lre - nr * lim) / den;
    const int pl = lane & 31, hh = lane >> 5, n16 = lane & 15, kq = lane >> 4;
    bf16x8 bfr[4];
#pragma unroll
    for (int blk = 0; blk < 4; ++blk) { const int ps = (blk & 1) * 32 + pl; const float cr = __shfl(cre, ps), ci = __shfl(cim, ps);
        const float* br = a.in[25] + ((size_t)pidx * 64 + ps) * 16 + 8 * hh; const float* bi = a.in[26] + ((size_t)pidx * 64 + ps) * 16 + 8 * hh;
        const f32x4 r0 = *(const f32x4*)br, r1 = *(const f32x4*)(br + 4), i0 = *(const f32x4*)bi, i1 = *(const f32x4*)(bi + 4);
        f32x4 v0, v1; if (blk < 2) { v0 = r0 * cr - i0 * ci; v1 = r1 * cr - i1 * ci; } else { v0 = i0 * cr + r0 * ci; v1 = i1 * cr + r1 * ci; }
        u32x4 pw; pw.x = pk2(v0.x, v0.y); pw.y = pk2(v0.z, v0.w); pw.z = pk2(v1.x, v1.y); pw.w = pk2(v1.z, v1.w); bfr[blk] = __builtin_bit_cast(bf16x8, pw); }
    bf16x8 cfr[4];
#pragma unroll
    for (int ks = 0; ks < 4; ++ks) { const int k0 = 32 * ks + 8 * kq; const float* src = (k0 < 64) ? a.in[27] + ((size_t)pidx * 16 + n16) * 64 + k0 : a.in[28] + ((size_t)pidx * 16 + n16) * 64 + (k0 - 64);
        const float sg = (k0 < 64) ? 1.f : -1.f; const f32x4 c0 = *(const f32x4*)src * sg, c1 = *(const f32x4*)(src + 4) * sg;
        u32x4 pw; pw.x = pk2(c0.x, c0.y); pw.y = pk2(c0.z, c0.w); pw.z = pk2(c1.x, c1.y); pw.w = pk2(c1.z, c1.w); cfr[ks] = __builtin_bit_cast(bf16x8, pw); }
    float sre = 0.f, sim = 0.f;
    if (seq >= 16) { const size_t si = ((size_t)(((seq - 16) * 4 + l) * 2 + dir) * 16 + g) * 64 + lane; sre = a.in[6][si]; sim = a.in[7][si]; }
    const bf16* U = (const bf16*)(a.ws + WS_UU) + (size_t)mbase * 256 + g * 16;
    float* Y = (float*)(a.ws + WS_H) + (size_t)dir * MT * 256 + (size_t)mbase * 256 + g * 16;
    if (!SPLIT) {
        s5_run<true>(wl, U, Y, L, dir, 0, L, bfr, cfr, ar, ai, sre, sim, lane);
        if (seq < 16) { const size_t so = ((size_t)((seq * 4 + l) * 2 + dir) * 16 + g) * 64 + lane; a.out[O_SRE + so] = sre; a.out[O_SIM + so] = sim; }
    } else {
        const int c_lo = w * 512, c_hi = c_lo + 512;
        float er = 0.f, ei = 0.f;
        if (w < 7) s5_run<false>(wl, U, Y, L, dir, c_lo, c_hi, bfr, cfr, ar, ai, er, ei, lane);
        xl[w * 128 + lane] = er; xl[w * 128 + 64 + lane] = ei;
        __syncthreads();
        float pr = ar, pi = ai;
#pragma unroll
        for (int q = 0; q < 9; ++q) { const float t_r = pr * pr - pi * pi, t_i = 2.f * pr * pi; pr = t_r; pi = t_i; }
        for (int j = 0; j < w; ++j) { const float e_r = xl[j * 128 + lane], e_i = xl[j * 128 + 64 + lane]; const float n_r = fmaf(pr, sre, fmaf(-pi, sim, e_r)), n_i = fmaf(pr, sim, fmaf(pi, sre, e_i)); sre = n_r; sim = n_i; }
        s5_run<true>(wl, U, Y, L, dir, c_lo, c_hi, bfr, cfr, ar, ai, sre, sim, lane);
        __syncthreads();
    }
}

DI void glu_item(const Args& a, LAS unsigned char* lds, int l, int item, int tid, int lane, int w) {
    const int m0 = item * 32;
    LAS bf16* YG = (LAS bf16*)lds;
    LAS float* YF32 = (LAS float*)(lds + 16896);
    const bf16* UU = (const bf16*)(a.ws + WS_UU); const float* YF = (const float*)(a.ws + WS_H); const float* YB = YF + (size_t)MT * 256;
    bf16* MIX = (bf16*)(a.ws + WS_PROJ);
    const int row = tid >> 4, c0 = (tid & 15) * 16; const size_t gro = (size_t)(m0 + row) * 256 + c0;
#pragma unroll
    for (int q = 0; q < 4; ++q) { const u32x2 ur = *(const u32x2*)(UU + gro + q * 4); const f32x4 yf = *(const f32x4*)(YF + gro + q * 4), yb = *(const f32x4*)(YB + gro + q * 4), dd = *(const f32x4*)(a.in[29] + l * 256 + c0 + q * 4);
        f32x4 y; y.x = dd.x * bflo(ur.x) + yf.x + yb.x; y.y = dd.y * bfhi(ur.x) + yf.y + yb.y; y.z = dd.z * bflo(ur.y) + yf.z + yb.z; y.w = dd.w * bfhi(ur.y) + yf.w + yb.w;
#pragma unroll
        for (int e = 0; e < 4; ++e) { const float v = y[e]; const float z = 0.7978845608028654f * (v + 0.044715f * v * v * v); const float th = 1.f - 2.f * __builtin_amdgcn_rcpf(1.f + __expf(2.f * z)); y[e] = 0.5f * v * (1.f + th); }
        *(LAS f32x4*)(YF32 + row * 260 + c0 + q * 4) = y; u32x2 o; o.x = pk2(y.x, y.y); o.y = pk2(y.z, y.w); *(LAS u32x2*)(YG + row * 264 + c0 + q * 4) = o; }
    __syncthreads();
    const int n16 = lane & 15, kq = lane >> 4;
    { const bf16* W = (const bf16*)(a.ws + WS_WGLU) + (size_t)l * 256 * 256 + (size_t)(w * 32 + n16) * 256 + 8 * kq;
      f32x4 acc[2][2];
#pragma unroll
      for (int c = 0; c < 2; ++c) { acc[c][0] = (f32x4){0.f, 0.f, 0.f, 0.f}; acc[c][1] = (f32x4){0.f, 0.f, 0.f, 0.f}; }
      small_gemm<2, 8, 264, 256>(YG, W, item + w, acc, n16, kq);
#pragma unroll
      for (int c = 0; c < 2; ++c) { const int col = w * 32 + c * 16 + n16; const float bg = a.in[31][l * 256 + col];
#pragma unroll
          for (int rb = 0; rb < 2; ++rb)
#pragma unroll
              for (int i = 0; i < 4; ++i) { const int rw = 16 * rb + 4 * kq + i; const float z = acc[c][rb][i] + bg; const float yv = YF32[rw * 260 + col]; YF32[rw * 260 + col] = yv * __builtin_amdgcn_rcpf(1.f + __expf(-z)); } } }
    __syncthreads();
    { u32x4 o0, o1; const LAS float* sp = YF32 + row * 260 + c0; const f32x4 a0 = *(const LAS f32x4*)sp, a1 = *(const LAS f32x4*)(sp + 4), a2 = *(const LAS f32x4*)(sp + 8), a3 = *(const LAS f32x4*)(sp + 12);
      o0.x = pk2(a0.x, a0.y); o0.y = pk2(a0.z, a0.w); o0.z = pk2(a1.x, a1.y); o0.w = pk2(a1.z, a1.w); o1.x = pk2(a2.x, a2.y); o1.y = pk2(a2.z, a2.w); o1.z = pk2(a3.x, a3.y); o1.w = pk2(a3.z, a3.w);
      bf16* dst = MIX + (size_t)(m0 + row) * 1024 + 768 + c0; *(u32x4*)dst = o0; *(u32x4*)(dst + 8) = o1; }
    __syncthreads();
}

typedef __attribute__((address_space(1))) unsigned gu32;
#define XB_TMO      128
#define XB_XCNT(j)  (256  + 64 * (j))
#define XB_XSUB(j)  (1280 + 64 * (j))
#define XB_XGEN(j)  (2304 + 64 * (j))
#define XB_TOP      3328
#define XB_TOPGEN   3392
#define XCD_BAR_WORDS 3456
#define XB_SPIN_CAP (1u << 18)

__device__ __forceinline__ unsigned xb_ld(unsigned* p)              { return __hip_atomic_load(p, __ATOMIC_RELAXED, __HIP_MEMORY_SCOPE_AGENT); }
__device__ __forceinline__ unsigned xb_add(unsigned* p, unsigned v) { return __hip_atomic_fetch_add(p, v, __ATOMIC_RELAXED, __HIP_MEMORY_SCOPE_AGENT); }
__device__ __forceinline__ unsigned xb_xcc_id() { return (unsigned)__builtin_amdgcn_s_getreg((3 << 11) | 20) & 0xFu; }
#define XB_SPIN(cond, bar) do { unsigned _sp = 0; while (cond) { __builtin_amdgcn_s_sleep(1); \
    if ((++_sp & 255u) == 0u) { if (xb_ld(&(bar)[XB_TMO])) break; if (_sp > XB_SPIN_CAP) { atomicAdd(&(bar)[XB_TMO], 1u); break; } } } } while (0)

struct XcdBarrier {
    unsigned* bar; unsigned x;
    volatile LAS unsigned* st;
};

__device__ __forceinline__ XcdBarrier xcd_barrier_post(unsigned* bar, volatile LAS unsigned* st) {
    XcdBarrier b; b.bar = bar; b.x = xb_xcc_id(); b.st = st;
    if (threadIdx.x == 0) (void)xb_add(&bar[XB_XCNT(b.x)], 1u);
    return b;
}
__device__ __forceinline__ void xcd_barrier_complete(unsigned* bar, unsigned x, unsigned& nloc, unsigned& nx) {
    const unsigned G = gridDim.x * gridDim.y * gridDim.z;
    unsigned sum, cnt, mine, sp = 0u;
    for (;;) {
        sum = 0u; cnt = 0u; mine = 0u;
#pragma unroll
        for (unsigned j = 0; j < 16; ++j) { const unsigned c = xb_ld(&bar[XB_XCNT(j)]); sum += c; cnt += (c > 0u) ? 1u : 0u; mine = (j == x) ? c : mine; }
        if (sum == G) break;
        __builtin_amdgcn_s_sleep(1);
        if ((++sp & 255u) == 0u) { if (xb_ld(&bar[XB_TMO])) break; if (sp > XB_SPIN_CAP) { atomicAdd(&bar[XB_TMO], 1u); break; } }
    }
    nloc = mine > 0u ? mine : 1u; nx = cnt > 0u ? cnt : 1u;
}

__device__ __forceinline__ void xcd_barrier(const XcdBarrier& b) {
    asm volatile("s_waitcnt vmcnt(0)" ::: "memory");
    __syncthreads();
    if (threadIdx.x == 0) {
        unsigned* bar = b.bar;
        __builtin_amdgcn_s_waitcnt(0);
        unsigned nloc = b.st[0], nx = b.st[1];
        if (nloc == 0u) { xcd_barrier_complete(bar, b.x, nloc, nx); b.st[0] = nloc; b.st[1] = nx; }
        const unsigned old = xb_add(&bar[XB_XSUB(b.x)], 1u);
        const unsigned gen = old / nloc;
        if (old + 1u == (gen + 1u) * nloc) {
            __builtin_amdgcn_fence(__ATOMIC_RELEASE, "agent");
            asm volatile("s_waitcnt vmcnt(0)" ::: "memory");
            const unsigned og = xb_add(&bar[XB_TOP], 1u);
            const unsigned tg = og / nx;
            if (og + 1u == (tg + 1u) * nx) xb_add(&bar[XB_TOPGEN], 1u);
            else XB_SPIN(xb_ld(&bar[XB_TOPGEN]) == tg, bar);
            __builtin_amdgcn_fence(__ATOMIC_ACQUIRE, "agent");
            xb_add(&bar[XB_XGEN(b.x)], 1u);
            asm volatile("s_waitcnt vmcnt(0)" ::: "memory");
        } else {
            XB_SPIN(xb_ld(&bar[XB_XGEN(b.x)]) == gen, bar);
            __builtin_amdgcn_fence(__ATOMIC_ACQUIRE, "agent");
            asm volatile("s_waitcnt vmcnt(0)" ::: "memory");
        }
    }
    __syncthreads();
}

#define ATT_UNITS(ABLV) \
            for (int uu = vcu; uu < 256 + 1536; uu += G) { \
                int seq, h, m0, Lk; bool mla; size_t kr0; \
                if (uu < 256) { const int s = uu; if ((s & 3) == 0) continue; const int pu = (s >> 2) * 3 + (s & 3) - 1; seq = pu / 12; const int hx = pu % 12; mla = hx >= 6; h = mla ? hx - 6 : hx; m0 = seq * 256; Lk = 256; kr0 = (size_t)m0; } \
                else { const int u = uu - 256; const int pass = u >> 8, c = u & 255, idx = (pass >> 1) * 256 + c; const int b = idx / 96; h = (idx % 96) >> 4; const int qb = idx & 15; \
                       seq = 16 + b; mla = (pass & 1) != 0; m0 = MP + b * 4096 + qb * 256; Lk = LKS; kr0 = (size_t)MP + (size_t)b * LKS; } \
                if (!mla) attn_unit<64, ABLV>(lds, QA + (size_t)m0 * 384 + h * 64, 384, KA + kr0 * 128 + (h / 3) * 64, 128, VTA + vtbase(seq, 128) + (size_t)(h / 3) * 64 * Lk, Lk, MIX + (size_t)m0 * 1024 + h * 64, tid); \
                else attn_unit<96, ABLV>(lds, QB + (size_t)m0 * 576 + h * 96, 576, KB + kr0 * 576 + h * 96, 576, VTB + vtbase(seq, 384) + (size_t)h * 64 * Lk, Lk, MIX + (size_t)m0 * 1024 + 384 + h * 64, tid); \
            }
__global__ void __launch_bounds__(512, 2) mega(Args a) {
    extern __shared__ __attribute__((aligned(16))) unsigned char lds_raw[];
    LAS unsigned char* lds = (LAS unsigned char*)lds_raw;
    cg::grid_group grid = cg::this_grid();
    const int G = gridDim.x, bx = blockIdx.x;
#define LAUNDER_TID int tid = threadIdx.x; asm volatile("" : "+v"(tid)); const int lane = tid & 63, w = __builtin_amdgcn_readfirstlane(tid >> 6); const int gw = vcu * 8 + w
    const int vcu = (G % 8 == 0) ? (bx % 8) * (G / 8) + bx / 8 : bx;
    const int ngw = G * 8;
    int ph = 0;
    volatile LAS unsigned* bar_st = (volatile LAS unsigned*)(lds + LDS_BYTES - 64);
    if (threadIdx.x < 2) bar_st[threadIdx.x] = 0u;
    __syncthreads();
    XcdBarrier xbar = xcd_barrier_post((unsigned*)(a.ws + WS_BAR), bar_st);
#ifndef PMASK
#define PMASK 0xFFFF
#endif
#define PH_ON (a.ph_lo <= ph && ph < a.ph_hi)
#define PM(b) ((PMASK >> (b)) & 1)
#ifndef REPMASK
#define REPMASK 0
#endif
#define REPS(b) (((REPMASK >> (b)) & 1) ? 2 : 1)
#define PH_END do { if (a.ph_lo <= ph && ph + 1 < a.ph_hi) { if (ph == 0) grid.sync(); else xcd_barrier(xbar); } ++ph; } while (0)
    float* X = a.out;
    bf16* H = (bf16*)(a.ws + WS_H);
    const float* MOD = (const float*)(a.ws + WS_MOD);

    if (PM(0) && PH_ON) for (int rep = 0; rep < REPS(0); ++rep) { LAUNDER_TID;
        p0_convert(a, lds, gw, ngw, w, lane);
        __syncthreads();
        for (int it = bx; it < 768; it += G) ada_partial_item(a, lds, it, tid);
    }
    PH_END;
    if (PM(1) && PH_ON) for (int rep = 0; rep < REPS(1); ++rep) { LAUNDER_TID;
        const float* P = (const float*)(a.ws + WS_MODP); float* Mo = (float*)(a.ws + WS_MOD);
        for (int i = bx * 512 + tid; i < NLAYER * 9 * 6144; i += G * 512) { const int l = i / (9 * 6144), r = i % (9 * 6144), n = r % 6144; float s = a.in[13][l * 6144 + n];
#pragma unroll
            for (int ks = 0; ks < 8; ++ks) s += P[(size_t)(l * 8 + ks) * 9 * 6144 + r];
            Mo[i] = s; }
    }
    PH_END;
    if (PM(2) && PH_ON) for (int rep = 0; rep < REPS(2); ++rep) { LAUNDER_TID; norm_rows(a.in[0], a.in[1], a.in[10], MOD, 0, 1024, H, gw, ngw, lane); }
    PH_END;

#pragma unroll 1
    for (int l = 0; l < NLAYER; ++l) {
        const float* mod_l = MOD + (size_t)l * 9 * 6144;
        if (PM(3) && PH_ON) for (int rep = 0; rep < REPS(3); ++rep) {
            pg8::Gemm g{H, (const bf16*)(a.ws + WS_WIN) + (size_t)l * 1536 * 1024, MT, NINP, 1024}; pg8::StaticOrder S; S.init(MT, NINP, G, bx);
            pg8::EpiBf16<0> E{(bf16*)(a.ws + WS_PROJ), NINP, nullptr, 0, 0, 1.f};
            pg8::gemm_phase<pg8::EpiBf16<0>, pg8::StaticOrder, true, true>(lds, g, S, E);
        }
        PH_END;
        if (PM(4) && PH_ON) for (int rep = 0; rep < REPS(4); ++rep) { LAUNDER_TID;
            post_tables(lds, tid); __syncthreads();
#ifdef PABLX
            for (int it = vcu; it < 1152 + 128; it += G) post_item<PABLX>(a, lds, l, it, tid, lane, w);
#endif
            for (int it = vcu; it < 1152 + 128; it += G) post_item<0>(a, lds, l, it, tid, lane, w);
        }
        PH_END;
        if (PM(5) && PH_ON) for (int rep = 0; rep < REPS(5); ++rep) { LAUNDER_TID;
            const bf16* QA = (const bf16*)(a.ws + WS_QA); const bf16* QB = (const bf16*)(a.ws + WS_QB); const bf16* KA = (const bf16*)(a.ws + WS_KA); const bf16* KB = (const bf16*)(a.ws + WS_KB);
            const bf16* VTA = (const bf16*)(a.ws + WS_VTA); const bf16* VTB = (const bf16*)(a.ws + WS_VTB); bf16* MIX = (bf16*)(a.ws + WS_PROJ);
            for (int s = vcu; s < 256; s += G) {
                s5_task<true>(a, (LAS float*)(lds + w * 16896), (LAS float*)(lds + 135168), l, 16 + (s >> 5), (s & 31) >> 1, s & 1, lane, w);
                if (w < 2) { const int id = s * 2 + w; s5_task<false>(a, (LAS float*)(lds + w * 16896), (LAS float*)(lds + 135168), l, id >> 5, (id & 31) >> 1, id & 1, lane, w); }
            }
            __syncthreads();
            ATT_UNITS(0)
#ifdef ABLX
            __syncthreads();
            ATT_UNITS(ABLX)
#endif
        }
        PH_END;
        if (PM(6) && PH_ON) for (int rep = 0; rep < REPS(6); ++rep) { LAUNDER_TID; for (int it = vcu; it < 1152; it += G) glu_item(a, lds, l, it, tid, lane, w); }
        PH_END;
        if (PM(7) && PH_ON) {
            pg8::Gemm g{(const bf16*)(a.ws + WS_PROJ), (const bf16*)(a.ws + WS_WOUT) + (size_t)l * 1024 * 1024, MT, 1024, 1024}; pg8::StaticOrder S; S.init(MT, 1024, G, bx);
            EpiRes E{l == 0 ? a.in[0] : X, l == 0 ? a.in[1] : X + (size_t)MP * 1024, X, mod_l + 2048};
            pg8::gemm_phase<EpiRes, pg8::StaticOrder, true, true>(lds, g, S, E);
        }
        PH_END;
        if (PM(8) && PH_ON) for (int rep = 0; rep < REPS(8); ++rep) { LAUNDER_TID; norm_rows(X, X + (size_t)MP * 1024, a.in[11] + l * 1024, mod_l, 3072, 4096, H, gw, ngw, lane); }
        PH_END;
        if (PM(9) && PH_ON) for (int rep = 0; rep < REPS(9); ++rep) {
            pg8::Gemm g{H, (const bf16*)(a.ws + WS_WF1) + (size_t)l * 5632 * 1024, MT, NF1, 1024}; pg8::StaticOrder S; S.init(MT, NF1, G, bx);
            EpiSwiglu E{(bf16*)(a.ws + WS_HDN)};
            pg8::gemm_phase<EpiSwiglu, pg8::StaticOrder, true, true>(lds, g, S, E);
        }
        PH_END;
        if (PM(10) && PH_ON) {
            pg8::Gemm g{(const bf16*)(a.ws + WS_HDN), (const bf16*)(a.ws + WS_WF2) + (size_t)l * 1024 * 2816, MT, 1024, DFF}; pg8::StaticOrder S; S.init(MT, 1024, G, bx);
            EpiRes E{X, X + (size_t)MP * 1024, X, mod_l + 5120};
            pg8::gemm_phase<EpiRes, pg8::StaticOrder, true, true>(lds, g, S, E);
        }
        PH_END;
        if (PM(11) && PH_ON) { LAUNDER_TID;
            if (l + 1 < NLAYER) norm_rows(X, X + (size_t)MP * 1024, a.in[10] + (l + 1) * 1024, mod_l + 9 * 6144, 0, 1024, H, gw, ngw, lane);
            else final_norm_rows(X, a.in[35], gw, ngw, lane);
        }
        PH_END;
    }
}

extern "C" void kernel_launch(void* const* d_in, const int* in_sizes, int n_in, void* d_out, int out_size, void* d_ws, size_t ws_size, hipStream_t stream) {
    static int grid = 0;
    if (grid == 0) {
        if (n_in != 36 || ws_size < WS_TOTAL) { fprintf(stderr, "kernel_launch: unexpected n_in %d / ws %zu (need %zu)\n", n_in, ws_size, (size_t)WS_TOTAL); grid = -1; return; }
        int dev = 0, cus = 0, per_cu = 0;
        hipGetDevice(&dev); hipDeviceGetAttribute(&cus, hipDeviceAttributeMultiprocessorCount, dev);
        if (hipFuncSetAttribute((const void*)mega, hipFuncAttributeMaxDynamicSharedMemorySize, LDS_BYTES) != hipSuccess) fprintf(stderr, "kernel_launch: hipFuncSetAttribute failed\n");
        if (hipOccupancyMaxActiveBlocksPerMultiprocessor(&per_cu, (const void*)mega, 512, LDS_BYTES) != hipSuccess || per_cu < 1) { fprintf(stderr, "kernel_launch: occupancy query says %d\n", per_cu); per_cu = 1; }
        (void)hipGetLastError();
        grid = cus;
    }
    if (grid < 0) return;
    Args a{};
    for (int i = 0; i < 36; ++i) a.in[i] = (const float*)d_in[i];
    a.out = (float*)d_out; a.ws = (unsigned char*)d_ws;
#if defined(MK_MULTI)
    for (int p = 0; p < NPHASE; ++p) { a.ph_lo = p; a.ph_hi = p + 1; hipLaunchKernelGGL(mega, dim3(grid), dim3(512), LDS_BYTES, stream, a); }
#else
    a.ph_lo = 0; a.ph_hi = NPHASE;
    if (hipMemsetAsync((char*)d_ws + WS_BAR, 0, 16384, stream) != hipSuccess) fprintf(stderr, "kernel_launch: memset failed\n");
    void* args[] = {&a};
    hipError_t e = hipLaunchCooperativeKernel((const void*)mega, dim3(grid), dim3(512), args, LDS_BYTES, stream);
    if (e != hipSuccess) fprintf(stderr, "kernel_launch: cooperative launch failed: %s (grid %d)\n", hipGetErrorString(e), grid);
#endif
}
```

```cpp
#include <hip/hip_runtime.h>
#include <hip/hip_cooperative_groups.h>
#include <cstdio>
#include <cstdint>
namespace cg = cooperative_groups;
namespace pg8 {
#define PG8_LAS __attribute__((address_space(3)))
typedef unsigned short bf16_t;
typedef short bf16x8 __attribute__((ext_vector_type(8)));
typedef float f32x4 __attribute__((ext_vector_type(4)));
typedef unsigned u32x4 __attribute__((ext_vector_type(4)));
constexpr int BM = 256, BK = 64, HALF = 128, HTB = HALF * BK * 2  , STAGE_BYTES = 8 * HTB, NXCD = 8, WGM = 2;

__host__ __device__ __forceinline__ int lds_byte(int r, int c) { const int st = (r >> 4) * 2 + (c >> 5), rr = r & 15, cc = c & 31, ob = rr * 64 + cc * 2; return st * 1024 + (ob ^ (((ob >> 9) & 1) << 5)); }
__host__ __device__ __forceinline__ void stage_rc(int b, int& R, int& C) { const int st = b / 1024, sb = b % 1024, swz = sb ^ (((sb >> 9) & 1) << 5); R = (st >> 1) * 16 + swz / 64; C = (st & 1) * 32 + (swz % 64) / 2; }
__host__ __device__ __forceinline__ int perm32(int rho) { const int n = rho >> 4, i = rho & 15; return 8 * (i >> 2) + 4 * n + (i & 3); }

struct Unit { int pm, pn; };
struct Gemm { const bf16_t* A; const bf16_t* Bt; int M, N, K; };

struct StaticOrder {
    int nM, nN, nwg, G, c;
    __host__ __device__ void init(int M, int N, int G_, int c_) { nM = M / BM; nN = N / BM; nwg = nM * nN; G = G_; c = c_; }
    __host__ __device__ bool next(int i, Unit& u) const {
        const long L = (long)i * G + c; if (L >= nwg) return false;
        int wgid = (int)L; { const int q = nwg / NXCD, r = nwg % NXCD, xcd = wgid % NXCD, off = wgid / NXCD; wgid = (xcd < r ? xcd * (q + 1) : r * (q + 1) + (xcd - r) * q) + off; }
        const int nig = WGM * nN, gid = wgid / nig, fm = gid * WGM, gsz = (nM - fm) < WGM ? (nM - fm) : WGM;
        u.pm = fm + ((wgid % nig) % gsz); u.pn = (wgid % nig) / gsz; return true;
    }
    __device__ __forceinline__ void a_ready(const Unit&) const {}
    __device__ __forceinline__ void done(const Unit&) const {}
};

__device__ __forceinline__ unsigned cvt_pk_bf16(float lo, float hi) { unsigned r; asm volatile("v_cvt_pk_bf16_f32 %0, %1, %2" : "=v"(r) : "v"(lo), "v"(hi)); return r; }
typedef float f32x2 __attribute__((ext_vector_type(2)));
__device__ __forceinline__ f32x2 gelu_pk(f32x2 v) {
    const f32x2 av = __builtin_elementwise_abs(v), d = av * 0.2316418882f + 1.0f;
    f32x2 t; t.x = __builtin_amdgcn_rcpf(d.x); t.y = __builtin_amdgcn_rcpf(d.y);
    f32x2 q = t * 0.5307027145f + (-0.7265760135f); q = q * t + 0.7107068705f; q = q * t + (-0.142248368f); q = q * t + 0.127414796f; q = q * t;
    const f32x2 s = (v * v) * (-0.72134752044f);
    f32x2 e; e.x = __builtin_amdgcn_exp2f(s.x); e.y = __builtin_amdgcn_exp2f(s.y);
    const f32x2 m = v * (q * e), r = v - m;
    f32x2 o; o.x = v.x < 0.f ? m.x : r.x; o.y = v.y < 0.f ? m.y : r.y; return o;
}

template <int ACT  > struct EpiBf16 {
    static constexpr bool PERM = true, AFTER_DRAIN = false; static_assert(ACT == 0 || ACT == 1, "EpiBf16: ACT is 0 (none) or 1 (gelu_pk)");
    bf16_t* O; int ldc; const float* bias; int split_cols; size_t split_stride; float scale0;
    __device__ __forceinline__ void operator()(const f32x4 (&acc)[2][2][4][2], const Unit& u, int wr, int wc, int fr, int fq) const {
        const int row0 = u.pm * BM + wr * 64 + fr; int colt = u.pn * BM; bf16_t* base = O;
        float sc = 1.f; if (split_cols) { const int t = colt / split_cols; base += (size_t)t * split_stride; colt -= t * split_cols; if (t == 0) sc = scale0; }
        const int col0 = colt + wc * 32 + 8 * fq, bcol0 = u.pn * BM + wc * 32 + 8 * fq;
        f32x4 bv[2][2];
#pragma unroll
        for (int bj = 0; bj < 2; ++bj)
#pragma unroll
            for (int n = 0; n < 2; ++n) bv[bj][n] = bias ? *(const f32x4*)(bias + bcol0 + bj * HALF + 4 * n) : (f32x4){0.f, 0.f, 0.f, 0.f};
#pragma unroll
        for (int ai = 0; ai < 2; ++ai)
#pragma unroll
            for (int m = 0; m < 4; ++m) { bf16_t* rowp = base + (size_t)(row0 + ai * HALF + m * 16) * ldc + col0;
#pragma unroll
                for (int bj = 0; bj < 2; ++bj) { f32x4 v0 = acc[ai][bj][m][0] + bv[bj][0], v1 = acc[ai][bj][m][1] + bv[bj][1];
                    if (ACT == 1) { f32x2 a = gelu_pk((f32x2){v0[0], v0[1]}), b = gelu_pk((f32x2){v0[2], v0[3]}), c = gelu_pk((f32x2){v1[0], v1[1]}), d = gelu_pk((f32x2){v1[2], v1[3]});
                        v0 = (f32x4){a.x, a.y, b.x, b.y}; v1 = (f32x4){c.x, c.y, d.x, d.y}; }
                    v0 = v0 * sc; v1 = v1 * sc; u32x4 w; w.x = cvt_pk_bf16(v0[0], v0[1]); w.y = cvt_pk_bf16(v0[2], v0[3]); w.z = cvt_pk_bf16(v1[0], v1[1]); w.w = cvt_pk_bf16(v1[2], v1[3]);
                    *(u32x4*)(rowp + bj * HALF) = w; } }
    }
};
template <class Epi, class Sched, bool ALIGN_EPI = false, bool SP2 = false>
__device__ __forceinline__ void gemm_phase(PG8_LAS unsigned char* lds, const Gemm g, const Sched& S, const Epi& E) {
    int tid_ = threadIdx.x; asm volatile("" : "+v"(tid_));
    const int tid = tid_, wid = __builtin_amdgcn_readfirstlane(tid >> 6), lane = tid & 63, wr = wid >> 2, wc = wid & 3, fr = lane & 15, fq = lane >> 4;
    const int K = g.K, nt = K / BK;
    unsigned voffA[2], voffB[2];
#pragma unroll
    for (int i = 0; i < 2; ++i) { int R, C; stage_rc(tid * 16 + i * 8192, R, C); const int Rb = Epi::PERM ? ((R & ~31) + perm32(R & 31)) : R;
        voffA[i] = (unsigned)(R * K + C) * 2u; voffB[i] = (unsigned)(Rb * K + C) * 2u; }
    const size_t kstep = (size_t)(BK * 2);
    const size_t hstep = (size_t)HALF * K * 2;
    const size_t tstep = 2 * hstep;
    const unsigned ldsw = (unsigned)wid * 1024u;
    const int aoff = lds_byte(wr * 64 + fr, fq * 8), boff = lds_byte(wc * 32 + fr, fq * 8);
#define PG8_SA(b, h) (((b) * 2 + (h)) * HTB)
#define PG8_SB(b, h) ((4 + (b) * 2 + (h)) * HTB)
#define PG8_STAGE(bufoff, gbase, voff) do { _Pragma("unroll") for (int _i = 0; _i < 2; ++_i) \
        __builtin_amdgcn_global_load_lds((const unsigned*)((const char*)(gbase) + (voff)[_i]), (PG8_LAS unsigned*)(lds + (bufoff) + ldsw + _i * 8192), 16, 0, 0); } while (0)
#define PG8_LDA(dst, b, h) do { _Pragma("unroll") for (int m = 0; m < 4; ++m) _Pragma("unroll") for (int k = 0; k < 2; ++k) dst[m][k] = *(const PG8_LAS bf16x8*)(lds + PG8_SA(b, h) + aoff + m * 2048 + k * 1024); } while (0)
#define PG8_LDB(dst, b, h) do { _Pragma("unroll") for (int n = 0; n < 2; ++n) _Pragma("unroll") for (int k = 0; k < 2; ++k) dst[n][k] = *(const PG8_LAS bf16x8*)(lds + PG8_SB(b, h) + boff + n * 2048 + k * 1024); } while (0)
#define PG8_MMA(ai, bj, At, Bt) do { __builtin_amdgcn_s_setprio(1); _Pragma("unroll") for (int m = 0; m < 4; ++m) _Pragma("unroll") for (int n = 0; n < 2; ++n) _Pragma("unroll") for (int k = 0; k < 2; ++k) \
        acc[ai][bj][m][n] = __builtin_amdgcn_mfma_f32_16x16x32_bf16(Bt[n][k], At[m][k], acc[ai][bj][m][n], 0, 0, 0); __builtin_amdgcn_s_setprio(0); } while (0)
#define PG8_WAIT_V(n) asm volatile("s_waitcnt vmcnt(" #n ")" ::: "memory")
#define PG8_WAIT_L(n) asm volatile("s_waitcnt lgkmcnt(" #n ")" ::: "memory")
#define PG8_BAR __builtin_amdgcn_s_barrier()
#define PG8_SCHED __builtin_amdgcn_sched_barrier(0)
    Unit cur, nxt; int ui = 0;
    if (!S.next(0, cur)) return;
    f32x4 acc[2][2][4][2];
#pragma unroll
    for (int a = 0; a < 2; ++a)
#pragma unroll
        for (int b = 0; b < 2; ++b)
#pragma unroll
            for (int m = 0; m < 4; ++m)
#pragma unroll
                for (int n = 0; n < 2; ++n) acc[a][b][m][n] = (f32x4){0.f, 0.f, 0.f, 0.f};
    bf16x8 At[4][2], B0[2][2], B1[2][2];
    const char* cA = (const char*)g.A + (size_t)cur.pm * tstep; const char* cB = (const char*)g.Bt + (size_t)cur.pn * tstep;
    S.a_ready(cur);
    if constexpr (SP2) {
        PG8_STAGE(PG8_SB(0, 0), cB, voffB); PG8_STAGE(PG8_SB(0, 1), cB + hstep, voffB); PG8_STAGE(PG8_SA(0, 0), cA, voffA); PG8_STAGE(PG8_SA(0, 1), cA + hstep, voffA);
        if (wr == 1) PG8_BAR;
        PG8_WAIT_V(2); PG8_BAR;
        PG8_STAGE(PG8_SB(1, 0), cB + kstep, voffB); PG8_STAGE(PG8_SA(1, 0), cA + kstep, voffA); PG8_STAGE(PG8_SB(1, 1), cB + hstep + kstep, voffB);
        PG8_WAIT_V(6); PG8_BAR;
    } else {
        PG8_STAGE(PG8_SB(0, 0), cB, voffB); PG8_STAGE(PG8_SA(0, 0), cA, voffA); PG8_STAGE(PG8_SB(0, 1), cB + hstep, voffB); PG8_STAGE(PG8_SA(0, 1), cA + hstep, voffA);
        if (wr == 1) PG8_BAR;
        PG8_WAIT_V(4); PG8_BAR;
        PG8_STAGE(PG8_SB(1, 0), cB + kstep, voffB); PG8_STAGE(PG8_SA(1, 0), cA + kstep, voffA); PG8_STAGE(PG8_SB(1, 1), cB + hstep + kstep, voffB);
        PG8_WAIT_V(6); PG8_BAR;
    }
    for (;;) {
        const bool has_next = S.next(ui + 1, nxt);
        const char* nA = has_next ? (const char*)g.A + (size_t)nxt.pm * tstep : cA; const char* nB = has_next ? (const char*)g.Bt + (size_t)nxt.pn * tstep : cB;
        for (int t = 0; t < nt; t += 2) {
            const bool last = (t == nt - 2);
            const char* a1 = cA + (size_t)(t + 1) * kstep;
            const char* a2 = last ? nA : cA + (size_t)(t + 2) * kstep; const char* b2 = last ? nB : cB + (size_t)(t + 2) * kstep;
            const char* a3 = a2 + kstep; const char* b3 = b2 + kstep;
            if (last && has_next) S.a_ready(nxt);
            if constexpr (SP2) {
            PG8_LDB(B0, 0, 0); PG8_LDB(B1, 0, 1); PG8_SCHED; PG8_LDA(At, 0, 0); PG8_STAGE(PG8_SA(1, 1), a1 + hstep, voffA);
            PG8_WAIT_V(8); PG8_WAIT_L(0); PG8_BAR; PG8_MMA(0, 0, At, B0); PG8_MMA(0, 1, At, B1); PG8_BAR; PG8_SCHED;
            PG8_LDA(At, 0, 1); PG8_STAGE(PG8_SB(0, 0), b2, voffB); PG8_STAGE(PG8_SB(0, 1), b2 + hstep, voffB); PG8_STAGE(PG8_SA(0, 0), a2, voffA);
            PG8_WAIT_V(8); PG8_WAIT_L(0); PG8_BAR; PG8_MMA(1, 0, At, B0); PG8_MMA(1, 1, At, B1); PG8_BAR; PG8_SCHED;
            PG8_LDB(B0, 1, 0); PG8_LDB(B1, 1, 1); PG8_SCHED; PG8_LDA(At, 1, 0); PG8_STAGE(PG8_SA(0, 1), a2 + hstep, voffA);
            PG8_WAIT_V(8); PG8_WAIT_L(0); PG8_BAR; PG8_MMA(0, 0, At, B0); PG8_MMA(0, 1, At, B1); PG8_BAR; PG8_SCHED;
            PG8_LDA(At, 1, 1); PG8_STAGE(PG8_SB(1, 0), b3, voffB); PG8_STAGE(PG8_SB(1, 1), b3 + hstep, voffB); PG8_STAGE(PG8_SA(1, 0), a3, voffA);
            PG8_WAIT_V(8); PG8_WAIT_L(0); PG8_BAR; PG8_MMA(1, 0, At, B0); PG8_MMA(1, 1, At, B1); PG8_BAR; PG8_SCHED;
            } else {
            PG8_LDB(B0, 0, 0); PG8_SCHED; PG8_LDA(At, 0, 0); PG8_STAGE(PG8_SA(1, 1), a1 + hstep, voffA);
            PG8_WAIT_L(8); PG8_BAR; PG8_WAIT_L(0); PG8_MMA(0, 0, At, B0); PG8_BAR; PG8_SCHED;
            PG8_LDB(B1, 0, 1); PG8_STAGE(PG8_SB(0, 0), b2, voffB);
            PG8_BAR; PG8_WAIT_L(0); PG8_MMA(0, 1, At, B1); PG8_BAR;
            PG8_LDA(At, 0, 1); PG8_STAGE(PG8_SA(0, 0), a2, voffA);
            PG8_BAR; PG8_WAIT_L(0); PG8_MMA(1, 0, At, B0); PG8_BAR; PG8_SCHED;
            PG8_STAGE(PG8_SB(0, 1), b2 + hstep, voffB);
            PG8_WAIT_V(6); PG8_BAR; PG8_MMA(1, 1, At, B1); PG8_BAR;
            PG8_LDB(B0, 1, 0); PG8_SCHED; PG8_LDA(At, 1, 0); PG8_STAGE(PG8_SA(0, 1), a2 + hstep, voffA);
            PG8_WAIT_L(8); PG8_BAR; PG8_WAIT_L(0); PG8_MMA(0, 0, At, B0); PG8_BAR; PG8_SCHED;
            PG8_LDB(B1, 1, 1); PG8_STAGE(PG8_SB(1, 0), b3, voffB);
            PG8_BAR; PG8_WAIT_L(0); PG8_MMA(0, 1, At, B1); PG8_BAR;
            PG8_LDA(At, 1, 1); PG8_STAGE(PG8_SA(1, 0), a3, voffA);
            PG8_BAR; PG8_WAIT_L(0); PG8_MMA(1, 0, At, B0); PG8_BAR; PG8_SCHED;
            PG8_STAGE(PG8_SB(1, 1), b3 + hstep, voffB);
            PG8_WAIT_V(6); PG8_BAR; PG8_MMA(1, 1, At, B1); PG8_BAR;
            }
        }
        if constexpr (ALIGN_EPI) { if (wr == 0) PG8_BAR; }
        if constexpr (!Epi::AFTER_DRAIN) { E(acc, cur, wr, wc, fr, fq); S.done(cur); }
        if (!has_next) break;
#pragma unroll
        for (int a = 0; a < 2; ++a)
#pragma unroll
            for (int b = 0; b < 2; ++b)
#pragma unroll
                for (int m = 0; m < 4; ++m)
#pragma unroll
                    for (int n = 0; n < 2; ++n) acc[a][b][m][n] = (f32x4){0.f, 0.f, 0.f, 0.f};
        cur = nxt; cA = nA; cB = nB; ++ui;
        if constexpr (ALIGN_EPI) { if (wr == 1) PG8_BAR; }
    }
    PG8_WAIT_V(0);
    if constexpr (!ALIGN_EPI) { if (wr == 0) PG8_BAR; }
    PG8_BAR;
    if constexpr (Epi::AFTER_DRAIN) { E.fused(acc, cur, wr, wc, fr, fq, lds, wid, lane); S.done(cur); }
#undef PG8_SA
#undef PG8_SB
#undef PG8_STAGE
#undef PG8_LDA
#undef PG8_LDB
#undef PG8_MMA
#undef PG8_WAIT_V
#undef PG8_WAIT_L
#undef PG8_BAR
#undef PG8_SCHED
}
}

#define DI __device__ __forceinline__
#define LAS __attribute__((address_space(3)))
typedef unsigned short bf16;
typedef short bf16x8 __attribute__((ext_vector_type(8)));
typedef float f32x4 __attribute__((ext_vector_type(4)));
typedef float f32x2 __attribute__((ext_vector_type(2)));
typedef float f32x16 __attribute__((ext_vector_type(16)));
typedef unsigned u32x4 __attribute__((ext_vector_type(4)));
typedef unsigned u32x2 __attribute__((ext_vector_type(2)));
typedef __bf16 bf16x2_t __attribute__((ext_vector_type(2)));

constexpr int DM = 1024, NPB = 16, NPL = 256, NSB = 8, NSL = 4096, PAST = 512, NLAYER = 4;
constexpr int MP = NPB * NPL;
constexpr int MS = NSB * NSL;
constexpr int MT = MP + MS;
constexpr int NINP = 1536, DFF = 2816, NF1 = 5632;
constexpr int LKS = NSL + PAST;
constexpr int KROWS = MP + NSB * LKS;
constexpr float EPS = 1e-6f;
constexpr float QSC_A = 0.125f * 1.4426950408889634f;
constexpr float QSC_B = 0.10206207261596575f * 1.4426950408889634f;
constexpr int LDS_BYTES = 147456;
constexpr int NPHASE = 3 + 9 * NLAYER;

constexpr size_t O_K = (size_t)MT * 1024, O_V = O_K + 2097152, O_CKV = O_V + 2097152, O_KR = O_CKV + 2097152, O_SRE = O_KR + 524288, O_SIM = O_SRE + 131072;

constexpr size_t WS_WIN = 0;
constexpr size_t WS_WOUT = WS_WIN + 4ull * 1536 * 1024 * 2;
constexpr size_t WS_WF1 = WS_WOUT + 4ull * 1024 * 1024 * 2;
constexpr size_t WS_WF2 = WS_WF1 + 4ull * 5632 * 1024 * 2;
constexpr size_t WS_WUQ = WS_WF2 + 4ull * 1024 * 2816 * 2;
constexpr size_t WS_WUKV = WS_WUQ + 4ull * 576 * 256 * 2;
constexpr size_t WS_WGLU = WS_WUKV + 4ull * 768 * 128 * 2;
constexpr size_t WS_MODP = WS_WGLU + 4ull * 256 * 256 * 2;
constexpr size_t WS_MOD = WS_MODP + 4ull * 8 * 9 * 6144 * 4;
constexpr size_t WS_H = WS_MOD + 4ull * 9 * 6144 * 4;
constexpr size_t WS_U0 = WS_H + (size_t)MT * 1024 * 2;
constexpr size_t WS_PROJ = WS_U0;
constexpr size_t WS_QA = WS_PROJ + (size_t)MT * 1536 * 2;
constexpr size_t WS_QB = WS_QA + (size_t)MT * 384 * 2;
constexpr size_t WS_KA = WS_QB + (size_t)MT * 576 * 2;
constexpr size_t WS_VTA = WS_KA + (size_t)KROWS * 128 * 2;
constexpr size_t WS_KB = WS_VTA + (size_t)KROWS * 128 * 2;
constexpr size_t WS_VTB = WS_KB + (size_t)KROWS * 576 * 2;
constexpr size_t WS_UU = WS_VTB + (size_t)KROWS * 384 * 2;
constexpr size_t WS_END = WS_UU + (size_t)MT * 256 * 2;
constexpr size_t WS_BAR = WS_END;
constexpr size_t WS_TOTAL = WS_END + 16384;
constexpr size_t WS_HDN = WS_U0;
static_assert(WS_HDN + (size_t)MT * 2816 * 2 <= WS_END, "hdn overlay");
static_assert(WS_TOTAL <= 536870912ull, "ws budget");

struct Args { const float* in[36]; float* out; unsigned char* ws; int ph_lo, ph_hi; };

DI unsigned pk2(float lo, float hi) { f32x2 v = {lo, hi}; bf16x2_t b = __builtin_convertvector(v, bf16x2_t); return __builtin_bit_cast(unsigned, b); }
DI unsigned short f2bf(float f) { return (unsigned short)(pk2(f, 0.f) & 0xffffu); }
DI float bf2f(unsigned short b) { return __uint_as_float(((unsigned)b) << 16); }
DI float bflo(unsigned u) { return __uint_as_float(u << 16); }
DI float bfhi(unsigned u) { return __uint_as_float(u & 0xffff0000u); }
DI float wave_sum(float v) {
#pragma unroll
    for (int o = 1; o < 64; o <<= 1) v += __shfl_xor(v, o);
    return v;
}
DI int crow(int r, int hi) { return (r & 3) + 8 * (r >> 2) + 4 * hi; }
DI int swap23(int r) { return (r & ~12) | ((r & 4) << 1) | ((r & 8) >> 1); }
DI int cond_of_row(int m) { return m < MP ? 0 : 1 + ((m - MP) >> 12); }
DI float rsq(float x) { return 1.0f / sqrtf(x); }
DI void sincos_acc(float y, float& s, float& c) {
    const float n = rintf(y * 0.6366197723675814f);
    float r = fmaf(n, -1.5707962513e+00f, y); r = fmaf(n, -7.5497894159e-08f, r); r = fmaf(n, -5.3903029534e-15f, r);
    const float r2 = r * r;
    float sp = fmaf(r2, 2.7557319e-6f, -1.9841270e-4f); sp = fmaf(sp, r2, 8.3333333e-3f); sp = fmaf(sp, r2, -1.6666667e-1f); sp = fmaf(sp * r2, r, r);
    float cp = fmaf(r2, 2.4801587e-5f, -1.3888889e-3f); cp = fmaf(cp, r2, 4.1666667e-2f); cp = fmaf(cp, r2, -0.5f); cp = fmaf(cp, r2, 1.0f);
    const int q = ((int)n) & 3;
    const float ss = (q & 1) ? cp : sp, cc = (q & 1) ? sp : cp;
    s = (q & 2) ? -ss : ss; c = ((q + 1) & 2) ? -cc : cc;
}
DI float expm1_acc(float x) {
    if (fabsf(x) < 0.35f) { float p = fmaf(x, 1.f / 40320.f, 1.f / 5040.f); p = fmaf(p, x, 1.f / 720.f); p = fmaf(p, x, 1.f / 120.f); p = fmaf(p, x, 1.f / 24.f); p = fmaf(p, x, 1.f / 6.f); p = fmaf(p, x, 0.5f); return fmaf(p * x, x, x); }
    return expf(x) - 1.f;
}
#define MFMA32(a, b, c) __builtin_amdgcn_mfma_f32_32x32x16_bf16((a), (b), (c), 0, 0, 0)
#define MFMA16(a, b, c) __builtin_amdgcn_mfma_f32_16x16x32_bf16((a), (b), (c), 0, 0, 0)
#define LDS_FENCE() asm volatile("s_waitcnt lgkmcnt(0)" ::: "memory")

struct EpiRes {
    static constexpr bool PERM = true, AFTER_DRAIN = false;
    const float* base_p; const float* base_s;
    float* out; const float* gate;
    DI void operator()(const pg8::f32x4 (&acc)[2][2][4][2], const pg8::Unit& u, int wr, int wc, int fr, int fq) const {
        const int row0 = u.pm * 256 + wr * 64 + fr; const int cnd = cond_of_row(u.pm * 256);
        const float* g = gate + cnd * 6144; const int col0 = u.pn * 256 + wc * 32 + 8 * fq;
        f32x4 gv[2][2];
#pragma unroll
        for (int bj = 0; bj < 2; ++bj)
#pragma unroll
            for (int n = 0; n < 2; ++n) gv[bj][n] = *(const f32x4*)(g + col0 + bj * 128 + n * 4);
        const float* bb = (u.pm * 256 < MP) ? base_p + (size_t)row0 * 1024 : base_s + (size_t)(row0 - MP) * 1024;
        float* oo = out + (size_t)row0 * 1024;
#pragma unroll
        for (int ai = 0; ai < 2; ++ai)
#pragma unroll
            for (int m = 0; m < 4; ++m) { const size_t ro = (size_t)(ai * 128 + m * 16) * 1024;
#pragma unroll
                for (int bj = 0; bj < 2; ++bj)
#pragma unroll
                    for (int n = 0; n < 2; ++n) { const int c = col0 + bj * 128 + n * 4; const f32x4 b = *(const f32x4*)(bb + ro + c); *(f32x4*)(oo + ro + c) = b + gv[bj][n] * acc[ai][bj][m][n]; } }
    }
};
struct EpiSwiglu {
    static constexpr bool PERM = true, AFTER_DRAIN = false;
    bf16* O;
    DI void operator()(const pg8::f32x4 (&acc)[2][2][4][2], const pg8::Unit& u, int wr, int wc, int fr, int fq) const {
        const int row0 = u.pm * 256 + wr * 64 + fr; const int hcol0 = u.pn * 128 + wc * 32 + 8 * fq;
#pragma unroll
        for (int ai = 0; ai < 2; ++ai)
#pragma unroll
            for (int m = 0; m < 4; ++m) { float v[8];
#pragma unroll
                for (int n = 0; n < 2; ++n) { const f32x4 g = acc[ai][0][m][n], up = acc[ai][1][m][n];
#pragma unroll
                    for (int e = 0; e < 4; ++e) v[4 * n + e] = g[e] * __builtin_amdgcn_rcpf(1.f + __expf(-g[e])) * up[e]; }
                u32x4 o; o.x = pk2(v[0], v[1]); o.y = pk2(v[2], v[3]); o.z = pk2(v[4], v[5]); o.w = pk2(v[6], v[7]);
                *(u32x4*)(O + (size_t)(row0 + ai * 128 + m * 16) * DFF + hcol0) = o; }
    }
};

DI int rowmap(int mode, int n) { if (mode == 0) return n; if (n < DFF) return 256 * (n >> 7) + (n & 127); n -= DFF; return 256 * (n >> 7) + 128 + (n & 127); }
DI void transpose_item(const float* W, int K, int N, bf16* WT, int row_off, int mode, LAS float* scr, int item, int lane) {
    const int nblk = N / 32, kb = item / nblk, nb = item % nblk, k0 = 64 * kb, n0 = 32 * nb;
#pragma unroll 8
    for (int i = 0; i < 32; ++i) { const int kk = 2 * i + (lane >> 5); scr[kk * 33 + (lane & 31)] = W[(size_t)(k0 + kk) * N + n0 + (lane & 31)]; }
    LDS_FENCE();
    const int c = lane & 7;
#pragma unroll
    for (int j = 0; j < 4; ++j) { const int n = (lane >> 3) + 8 * j; const LAS float* s = scr + (8 * c) * 33 + n;
        u32x4 o; o.x = pk2(s[0 * 33], s[1 * 33]); o.y = pk2(s[2 * 33], s[3 * 33]); o.z = pk2(s[4 * 33], s[5 * 33]); o.w = pk2(s[6 * 33], s[7 * 33]);
        *(u32x4*)(WT + (size_t)(row_off + rowmap(mode, n0 + n)) * K + k0 + 8 * c) = o; }
    LDS_FENCE();
}
DI void p0_convert(const Args& a, LAS unsigned char* lds, int gw, int ngw, int w, int lane) {
    LAS float* scr = (LAS float*)(lds + w * 16384);
    constexpr int I_IN = 16 * 41, I_OUT = 16 * 32, I_F1 = 16 * 176, I_F2 = 44 * 32, I_UQ = 4 * 18, I_UK = 2 * 12, I_GLU = 4 * 8;
    constexpr int PER = I_IN + I_OUT + I_F1 + I_F2 + I_UQ + 2 * I_UK + I_GLU;
    for (int it = gw; it < PER * NLAYER; it += ngw) {
        const int l = it / PER; int r = it % PER;
        if (r < I_IN) { transpose_item(a.in[14] + (size_t)l * 1024 * 1312, 1024, 1312, (bf16*)(a.ws + WS_WIN) + (size_t)l * 1536 * 1024, 0, 0, scr, r, lane); continue; } r -= I_IN;
        if (r < I_OUT) { transpose_item(a.in[32] + (size_t)l * 1024 * 1024, 1024, 1024, (bf16*)(a.ws + WS_WOUT) + (size_t)l * 1024 * 1024, 0, 0, scr, r, lane); continue; } r -= I_OUT;
        if (r < I_F1) { transpose_item(a.in[33] + (size_t)l * 1024 * 5632, 1024, 5632, (bf16*)(a.ws + WS_WF1) + (size_t)l * 5632 * 1024, 0, 1, scr, r, lane); continue; } r -= I_F1;
        if (r < I_F2) { transpose_item(a.in[34] + (size_t)l * 2816 * 1024, 2816, 1024, (bf16*)(a.ws + WS_WF2) + (size_t)l * 1024 * 2816, 0, 0, scr, r, lane); continue; } r -= I_F2;
        if (r < I_UQ) { transpose_item(a.in[19] + (size_t)l * 256 * 576, 256, 576, (bf16*)(a.ws + WS_WUQ) + (size_t)l * 576 * 256, 0, 0, scr, r, lane); continue; } r -= I_UQ;
        if (r < I_UK) { transpose_item(a.in[20] + (size_t)l * 128 * 384, 128, 384, (bf16*)(a.ws + WS_WUKV) + (size_t)l * 768 * 128, 0, 0, scr, r, lane); continue; } r -= I_UK;
        if (r < I_UK) { transpose_item(a.in[21] + (size_t)l * 128 * 384, 128, 384, (bf16*)(a.ws + WS_WUKV) + (size_t)l * 768 * 128, 384, 0, scr, r, lane); continue; } r -= I_UK;
        transpose_item(a.in[30] + (size_t)l * 256 * 256, 256, 256, (bf16*)(a.ws + WS_WGLU) + (size_t)l * 256 * 256, 0, 0, scr, r, lane);
    }
    for (int i = gw * 64 + lane; i < NLAYER * 28672; i += ngw * 64) { const int l = i / 28672, r = i % 28672;
        *(u32x4*)((bf16*)(a.ws + WS_WIN) + ((size_t)l * 1536 + 1312) * 1024 + (size_t)r * 8) = (u32x4){0u, 0u, 0u, 0u}; }
}
DI void ada_partial_item(const Args& a, LAS unsigned char* lds, int it, int tid) {
    const int l = it / 192, r = it % 192, cb = r >> 3, ks = r & 7;
    LAS float* s = (LAS float*)lds;
    LAS float* red = (LAS float*)(lds + 8192);
    const float* c_in = a.in[8]; const float* c_ctx = a.in[9];
    for (int i = tid; i < 9 * 128; i += 512) { const int c = i >> 7, k = i & 127, kk = ks * 128 + k; const float x = c == 0 ? c_ctx[kk] : c_in[(c - 1) * 1024 + kk]; s[i] = x / (1.f + expf(-x)); }
    __syncthreads();
    const int col = cb * 256 + (tid & 255), half = tid >> 8;
    const float* W = a.in[12] + ((size_t)l * 1024 + ks * 128 + half * 64) * 6144 + col;
    float acc[9];
#pragma unroll
    for (int c = 0; c < 9; ++c) acc[c] = 0.f;
#pragma unroll 4
    for (int k = 0; k < 64; ++k) { const float wv = W[(size_t)k * 6144];
#pragma unroll
        for (int c = 0; c < 9; ++c) acc[c] = fmaf(s[c * 128 + half * 64 + k], wv, acc[c]); }
    if (half == 1) {
#pragma unroll
        for (int c = 0; c < 9; ++c) red[c * 256 + (tid & 255)] = acc[c]; }
    __syncthreads();
    if (half == 0) { float* P = (float*)(a.ws + WS_MODP) + ((size_t)(l * 8 + ks) * 9) * 6144;
#pragma unroll
        for (int c = 0; c < 9; ++c) P[(size_t)c * 6144 + col] = acc[c] + red[c * 256 + tid]; }
    __syncthreads();
}

DI void norm_rows(const float* xp, const float* xs, const float* g, const float* mod_l, int sh_off, int sc_off, bf16* H, int gw, int ngw, int lane) {
    for (int m = gw; m < MT; m += ngw) {
        const float* xr = (m < MP) ? xp + (size_t)m * 1024 : xs + (size_t)(m - MP) * 1024;
        f32x4 v[4]; float ss = 0.f;
#pragma unroll
        for (int j = 0; j < 4; ++j) { v[j] = ((const f32x4*)xr)[lane + 64 * j]; ss += (v[j].x * v[j].x + v[j].y * v[j].y) + (v[j].z * v[j].z + v[j].w * v[j].w); }
        const float rstd = rsq(wave_sum(ss) * (1.f / 1024.f) + EPS);
        const float* md = mod_l + cond_of_row(m) * 6144;
        u32x2* o8 = (u32x2*)(H + (size_t)m * 1024);
#pragma unroll
        for (int j = 0; j < 4; ++j) { const int idx = 4 * (lane + 64 * j);
            const f32x4 gg = *(const f32x4*)(g + idx), sc = *(const f32x4*)(md + sc_off + idx), sh = *(const f32x4*)(md + sh_off + idx);
            const f32x4 o = v[j] * rstd * gg * (sc + 1.0f) + sh; u32x2 pk; pk.x = pk2(o.x, o.y); pk.y = pk2(o.z, o.w); o8[lane + 64 * j] = pk; }
    }
}
DI void final_norm_rows(float* X, const float* g, int gw, int ngw, int lane) {
    for (int m = gw; m < MT; m += ngw) {
        f32x4* xr = (f32x4*)(X + (size_t)m * 1024);
        f32x4 v[4]; float ss = 0.f;
#pragma unroll
        for (int j = 0; j < 4; ++j) { v[j] = xr[lane + 64 * j]; ss += (v[j].x * v[j].x + v[j].y * v[j].y) + (v[j].z * v[j].z + v[j].w * v[j].w); }
        const float rstd = rsq(wave_sum(ss) * (1.f / 1024.f) + EPS);
#pragma unroll
        for (int j = 0; j < 4; ++j) { const f32x4 gg = *(const f32x4*)(g + 4 * (lane + 64 * j)); xr[lane + 64 * j] = v[j] * rstd * gg; }
    }
}


template <int NB, int NK, int PA, int KW>
DI void small_gemm(const LAS bf16* A, const bf16* W, int krot, f32x4 (&acc)[NB][2], int n16, int kq) {
    bf16x8 bb[2][NB];
    { const int ks = krot & (NK - 1);
#pragma unroll
      for (int c = 0; c < NB; ++c) bb[0][c] = *(const bf16x8*)(W + (size_t)c * 16 * KW + ks * 32); }
#pragma unroll
    for (int i = 0; i < NK; ++i) { const int cur = i & 1, ks = (i + krot) & (NK - 1);
        if (i + 1 < NK) { const int kn = (i + 1 + krot) & (NK - 1);
#pragma unroll
            for (int c = 0; c < NB; ++c) bb[cur ^ 1][c] = *(const bf16x8*)(W + (size_t)c * 16 * KW + kn * 32); }
        const bf16x8 a0 = *(const LAS bf16x8*)(A + n16 * PA + ks * 32 + 8 * kq), a1 = *(const LAS bf16x8*)(A + (16 + n16) * PA + ks * 32 + 8 * kq);
        __builtin_amdgcn_sched_barrier(0);
#pragma unroll
        for (int c = 0; c < NB; ++c) { acc[c][0] = MFMA16(a0, bb[cur][c], acc[c][0]); acc[c][1] = MFMA16(a1, bb[cur][c], acc[c][1]); }
        __builtin_amdgcn_sched_barrier(0);
    }
}

constexpr int L2_TAB = 0;
constexpr int L2_ACQ = 12288;
constexpr int L2_ACKV = L2_ACQ + 16896;
constexpr int L2_QBS = L2_ACKV + 8704;
constexpr int L2_KBS = L2_QBS + 36864;
constexpr int L2_VTBS = L2_KBS + 36864;
constexpr int L2_VTAS = L2_VTBS + 24576;
static_assert(L2_VTAS + 8192 <= LDS_BYTES, "L2 LDS");
DI size_t vtbase(int seq, int C) { return seq < 16 ? (size_t)seq * C * 256 : (size_t)16 * C * 256 + (size_t)(seq - 16) * C * LKS; }

DI void post_tables(LAS unsigned char* lds, int tid) {
    LAS float* c16 = (LAS float*)(lds + L2_TAB); LAS float* s16 = c16 + 1024; LAS float* c8 = c16 + 2048; LAS float* s8 = c16 + 2560;
    for (int i = tid; i < 1024; i += 512) { const int p = i >> 4, f = i & 15; const float inv = exp2f(-(float)f * (13.287712379549449f / 16.f)); float s, c; sincos_acc((float)p * inv, s, c); c16[i] = c; s16[i] = s; }
    for (int i = tid; i < 512; i += 512) { const int p = i >> 3, f = i & 7; const float inv = exp2f(-(float)f * (13.287712379549449f / 8.f)); float s, c; sincos_acc((float)p * inv, s, c); c8[i] = c; s8[i] = s; }
}

template <int PABL>
DI void post_item(const Args& a, LAS unsigned char* lds, int l, int item, int tid, int lane, int w) {
    const bool is_cache = item >= 1152;
    int m0 = 0, seq, t0, krow0; bool sample;
    if (!is_cache) { m0 = item * 32;
        if (m0 < MP) { seq = m0 >> 8; t0 = m0 & 255; sample = false; krow0 = m0; }
        else { const int r = m0 - MP; seq = 16 + (r >> 12); t0 = r & 4095; sample = true; krow0 = MP + (seq - 16) * LKS + t0; } }
    else { const int j = item - 1152, b = j >> 4; seq = 16 + b; t0 = NSL + (j & 15) * 32; sample = true; krow0 = MP + b * LKS + t0; }
    const int Lk = seq < 16 ? 256 : LKS;
    const LAS float* c16 = (const LAS float*)(lds + L2_TAB); const LAS float* s16 = c16 + 1024; const LAS float* c8 = c16 + 2048; const LAS float* s8 = c16 + 2560;
    LAS bf16* ACQ = (LAS bf16*)(lds + L2_ACQ); LAS bf16* ACKV = (LAS bf16*)(lds + L2_ACKV);
    LAS bf16* QBS = (LAS bf16*)(lds + L2_QBS); LAS bf16* KBS = (LAS bf16*)(lds + L2_KBS);
    LAS bf16* VTBS = (LAS bf16*)(lds + L2_VTBS); LAS bf16* VTAS = (LAS bf16*)(lds + L2_VTAS);
    bf16* QA = (bf16*)(a.ws + WS_QA); bf16* QB = (bf16*)(a.ws + WS_QB); bf16* KA = (bf16*)(a.ws + WS_KA); bf16* KB = (bf16*)(a.ws + WS_KB);
    bf16* VTA = (bf16*)(a.ws + WS_VTA); bf16* VTB = (bf16*)(a.ws + WS_VTB); bf16* UU = (bf16*)(a.ws + WS_UU);
    const bf16* PROJ = (const bf16*)(a.ws + WS_PROJ);
    if (PABL & 1) {} else
    if (!is_cache) {
        const int hd = lane >> 3, sub = lane & 7;
        const float* nw = (hd < 6) ? a.in[15] + l * 64 : a.in[16] + l * 64;
        const f32x4 nw0 = *(const f32x4*)(nw + 4 * sub), nw1 = *(const f32x4*)(nw + 32 + 4 * sub);
        const int e2 = (lane < 16) ? 512 + 8 * lane : (lane < 48) ? 640 + 8 * (lane - 16) : 896 + 8 * (lane - 48);
        const float* n2p = (lane < 48) ? a.in[17] + l * 256 + 8 * ((lane - 16) & 31) : a.in[18] + l * 128 + 8 * (lane - 48);
        const f32x4 n20 = *(const f32x4*)n2p, n21 = *(const f32x4*)(n2p + 4);
        u32x2 qa0[4], qa1[4]; u32x4 ld2[4]; u32x2 kr0[4], kr1[4]; u32x4 ldu[4];
#pragma unroll
        for (int rr = 0; rr < 4; ++rr) { const bf16* pr = PROJ + (size_t)(m0 + 4 * w + rr) * NINP;
            qa0[rr] = *(const u32x2*)(pr + hd * 64 + 4 * sub); qa1[rr] = *(const u32x2*)(pr + hd * 64 + 32 + 4 * sub);
            ld2[rr] = *(const u32x4*)(pr + e2);
            if (lane < 4) { kr0[rr] = *(const u32x2*)(pr + 1024 + 4 * lane); kr1[rr] = *(const u32x2*)(pr + 1040 + 4 * lane); }
            else if (lane < 36) ldu[rr] = *(const u32x4*)(pr + 1056 + 8 * (lane - 4)); }
#pragma unroll
        for (int rr = 0; rr < 4; ++rr) {
            const int r = 4 * w + rr, m = m0 + r, t = t0 + r, trow = t >> 6, tcol = t & 63;
            const size_t orow = (size_t)((seq * 4 + l) * 256 + t);
            { float x0[4] = {bflo(qa0[rr].x), bfhi(qa0[rr].x), bflo(qa0[rr].y), bfhi(qa0[rr].y)}, x1[4] = {bflo(qa1[rr].x), bfhi(qa1[rr].x), bflo(qa1[rr].y), bfhi(qa1[rr].y)};
              float ss = (x0[0] * x0[0] + x0[1] * x0[1]) + (x0[2] * x0[2] + x0[3] * x0[3]) + (x1[0] * x1[0] + x1[1] * x1[1]) + (x1[2] * x1[2] + x1[3] * x1[3]);
              ss += __shfl_xor(ss, 1); ss += __shfl_xor(ss, 2); ss += __shfl_xor(ss, 4);
              const float rs = rsq(ss * (1.f / 64.f) + EPS);
#pragma unroll
              for (int e = 0; e < 4; ++e) { x0[e] *= rs * nw0[e]; x1[e] *= rs * nw1[e]; }
              if (hd >= 6 && !sample) { float* ok = a.out + O_K + (orow * 2 + (hd - 6)) * 64; *(f32x4*)(ok + 4 * sub) = (f32x4){x0[0], x0[1], x0[2], x0[3]}; *(f32x4*)(ok + 32 + 4 * sub) = (f32x4){x1[0], x1[1], x1[2], x1[3]}; }
              if (sample) { const int p16 = (sub < 4) ? trow : tcol; const f32x4 cs = *(const LAS f32x4*)(c16 + p16 * 16 + 4 * (sub & 3)), sn = *(const LAS f32x4*)(s16 + p16 * 16 + 4 * (sub & 3));
#pragma unroll
                  for (int e = 0; e < 4; ++e) { const float a1 = x0[e], a2 = x1[e]; x0[e] = a1 * cs[e] - a2 * sn[e]; x1[e] = a1 * sn[e] + a2 * cs[e]; } }
              const float sc = (hd < 6) ? QSC_A : 1.f;
              u32x2 o0, o1; o0.x = pk2(x0[0] * sc, x0[1] * sc); o0.y = pk2(x0[2] * sc, x0[3] * sc); o1.x = pk2(x1[0] * sc, x1[1] * sc); o1.y = pk2(x1[2] * sc, x1[3] * sc);
              bf16* dst = (hd < 6) ? QA + (size_t)m * 384 + hd * 64 : KA + (size_t)(krow0 + r) * 128 + (hd - 6) * 64;
              *(u32x2*)(dst + 4 * sub) = o0; *(u32x2*)(dst + 32 + 4 * sub) = o1; }
            { float x[8] = {bflo(ld2[rr].x), bfhi(ld2[rr].x), bflo(ld2[rr].y), bfhi(ld2[rr].y), bflo(ld2[rr].z), bfhi(ld2[rr].z), bflo(ld2[rr].w), bfhi(ld2[rr].w)};
              float ss = (x[0] * x[0] + x[1] * x[1]) + (x[2] * x[2] + x[3] * x[3]) + (x[4] * x[4] + x[5] * x[5]) + (x[6] * x[6] + x[7] * x[7]);
              ss += __shfl_xor(ss, 1); ss += __shfl_xor(ss, 2); ss += __shfl_xor(ss, 4); ss += __shfl_xor(ss, 8);
              const float scq = __int_as_float(__builtin_amdgcn_readlane(__float_as_int(ss), 16)) + __int_as_float(__builtin_amdgcn_readlane(__float_as_int(ss), 32));
              const float skv = __int_as_float(__builtin_amdgcn_readlane(__float_as_int(ss), 48));
              if (lane < 16) {
                  if (!sample) { float* ov = a.out + O_V + orow * 128 + 8 * lane; *(f32x4*)ov = (f32x4){x[0], x[1], x[2], x[3]}; *(f32x4*)(ov + 4) = (f32x4){x[4], x[5], x[6], x[7]}; }
#pragma unroll
                  for (int e = 0; e < 8; ++e) VTAS[(8 * lane + e) * 32 + swap23(r)] = f2bf(x[e]);
              } else if (lane < 48) {
                  const float rs = rsq(scq * (1.f / 256.f) + EPS);
                  u32x4 o; o.x = pk2(x[0] * rs * n20.x, x[1] * rs * n20.y); o.y = pk2(x[2] * rs * n20.z, x[3] * rs * n20.w); o.z = pk2(x[4] * rs * n21.x, x[5] * rs * n21.y); o.w = pk2(x[6] * rs * n21.z, x[7] * rs * n21.w);
                  *(LAS u32x4*)(ACQ + r * 264 + 8 * (lane - 16)) = o;
              } else {
                  const float rs = rsq(skv * (1.f / 128.f) + EPS);
                  const float y0 = x[0] * rs * n20.x, y1 = x[1] * rs * n20.y, y2 = x[2] * rs * n20.z, y3 = x[3] * rs * n20.w, y4 = x[4] * rs * n21.x, y5 = x[5] * rs * n21.y, y6 = x[6] * rs * n21.z, y7 = x[7] * rs * n21.w;
                  if (!sample) { float* oc = a.out + O_CKV + orow * 128 + 8 * (lane - 48); *(f32x4*)oc = (f32x4){y0, y1, y2, y3}; *(f32x4*)(oc + 4) = (f32x4){y4, y5, y6, y7}; }
                  u32x4 o; o.x = pk2(y0, y1); o.y = pk2(y2, y3); o.z = pk2(y4, y5); o.w = pk2(y6, y7);
                  *(LAS u32x4*)(ACKV + r * 136 + 8 * (lane - 48)) = o;
              } }
            if (lane < 4) {
                float x0[4] = {bflo(kr0[rr].x), bfhi(kr0[rr].x), bflo(kr0[rr].y), bfhi(kr0[rr].y)}, x1[4] = {bflo(kr1[rr].x), bfhi(kr1[rr].x), bflo(kr1[rr].y), bfhi(kr1[rr].y)};
                if (!sample) { float* ok = a.out + O_KR + orow * 32; *(f32x4*)(ok + 4 * lane) = (f32x4){x0[0], x0[1], x0[2], x0[3]}; *(f32x4*)(ok + 16 + 4 * lane) = (f32x4){x1[0], x1[1], x1[2], x1[3]}; }
                else { const int p8 = (lane < 2) ? trow : tcol; const f32x4 cs = *(const LAS f32x4*)(c8 + p8 * 8 + 4 * (lane & 1)), sn = *(const LAS f32x4*)(s8 + p8 * 8 + 4 * (lane & 1));
#pragma unroll
                    for (int e = 0; e < 4; ++e) { const float a1 = x0[e], a2 = x1[e]; x0[e] = a1 * cs[e] - a2 * sn[e]; x1[e] = a1 * sn[e] + a2 * cs[e]; } }
                u32x2 o0, o1; o0.x = pk2(x0[0], x0[1]); o0.y = pk2(x0[2], x0[3]); o1.x = pk2(x1[0], x1[1]); o1.y = pk2(x1[2], x1[3]);
#pragma unroll
                for (int h = 0; h < 6; ++h) { *(LAS u32x2*)(KBS + r * 576 + h * 96 + 64 + 4 * lane) = o0; *(LAS u32x2*)(KBS + r * 576 + h * 96 + 80 + 4 * lane) = o1; }
            } else if (lane < 36) *(u32x4*)(UU + (size_t)m * 256 + 8 * (lane - 4)) = ldu[rr];
        }
    } else {
        const int b = seq - 16;
#pragma unroll 1
        for (int rr = 0; rr < 4; ++rr) {
            const int r = 4 * w + rr, p = (t0 - NSL) + r;
            const size_t cb = (size_t)(b * 4 + l) * 512 + p;
            const float* ck = a.in[2] + cb * 128; const float* cv = a.in[3] + cb * 128; const float* cc = a.in[4] + cb * 128; const float* ckr = a.in[5] + cb * 32;
            KA[(size_t)(krow0 + r) * 128 + lane] = f2bf(ck[lane]); KA[(size_t)(krow0 + r) * 128 + 64 + lane] = f2bf(ck[64 + lane]);
            VTAS[lane * 32 + swap23(r)] = f2bf(cv[lane]); VTAS[(64 + lane) * 32 + swap23(r)] = f2bf(cv[64 + lane]);
            { const f32x2 v = *(const f32x2*)(cc + lane * 2); *(LAS unsigned*)(ACKV + r * 136 + lane * 2) = pk2(v.x, v.y); }
            if (lane < 32) { const unsigned short bb = f2bf(ckr[lane]);
#pragma unroll
                for (int h = 0; h < 6; ++h) KBS[r * 576 + h * 96 + 64 + lane] = bb; }
        }
    }
    __syncthreads();
    const int n16 = lane & 15, kq = lane >> 4;
    if (!(PABL & 2)) {
    if (!is_cache && w < 6) {
        const bf16* W = (const bf16*)(a.ws + WS_WUQ) + (size_t)l * 576 * 256 + (size_t)(w * 96 + n16) * 256 + 8 * kq;
        f32x4 acc[6][2];
#pragma unroll
        for (int c = 0; c < 6; ++c) { acc[c][0] = (f32x4){0.f, 0.f, 0.f, 0.f}; acc[c][1] = (f32x4){0.f, 0.f, 0.f, 0.f}; }
        small_gemm<6, 8, 264, 256>(ACQ, W, item * 3 + w, acc, n16, kq);
#pragma unroll
        for (int rb = 0; rb < 2; ++rb)
#pragma unroll
            for (int i = 0; i < 4; ++i) { const int row = 16 * rb + 4 * kq + i;
                if (sample) { const int t = t0 + row, p8 = (n16 < 8) ? (t >> 6) : (t & 63); const float c = c8[p8 * 8 + (n16 & 7)], s = s8[p8 * 8 + (n16 & 7)];
                    const float x1 = acc[4][rb][i], x2 = acc[5][rb][i]; acc[4][rb][i] = x1 * c - x2 * s; acc[5][rb][i] = x1 * s + x2 * c; }
#pragma unroll
                for (int c = 0; c < 6; ++c) QBS[row * 576 + w * 96 + c * 16 + n16] = f2bf(acc[c][rb][i] * QSC_B); }
    }
    {
        const bf16* W = (const bf16*)(a.ws + WS_WUKV) + (size_t)l * 768 * 128 + (size_t)(w * 96 + n16) * 128 + 8 * kq;
        f32x4 acc[6][2];
#pragma unroll
        for (int c = 0; c < 6; ++c) { acc[c][0] = (f32x4){0.f, 0.f, 0.f, 0.f}; acc[c][1] = (f32x4){0.f, 0.f, 0.f, 0.f}; }
        small_gemm<6, 4, 136, 128>(ACKV, W, item * 3 + w, acc, n16, kq);
#pragma unroll
        for (int c = 0; c < 6; ++c) { const int cb = w * 6 + c;
#pragma unroll
            for (int rb = 0; rb < 2; ++rb)
#pragma unroll
                for (int i = 0; i < 4; ++i) { const int row = 16 * rb + 4 * kq + i; const unsigned short v = f2bf(acc[c][rb][i]);
                    if (w < 4) KBS[row * 576 + (cb >> 2) * 96 + (cb & 3) * 16 + n16] = v;
                    else { const int cb2 = cb - 24; VTBS[((cb2 >> 2) * 64 + (cb2 & 3) * 16 + n16) * 32 + swap23(row)] = v; } } }
    }
    }
    __syncthreads();
    if (!(PABL & 4)) {
    if (!is_cache) for (int i = tid; i < 2304; i += 512) *(u32x4*)(QB + (size_t)m0 * 576 + (size_t)i * 8) = *(const LAS u32x4*)(QBS + i * 8);
    for (int i = tid; i < 2304; i += 512) *(u32x4*)(KB + (size_t)krow0 * 576 + (size_t)i * 8) = *(const LAS u32x4*)(KBS + i * 8);
    { bf16* dst = VTB + vtbase(seq, 384) + t0;
      for (int i = tid; i < 1536; i += 512) { const int d = i >> 2, ch = i & 3; *(u32x4*)(dst + (size_t)d * Lk + ch * 8) = *(const LAS u32x4*)(VTBS + d * 32 + ch * 8); } }
    { bf16* dst = VTA + vtbase(seq, 128) + t0; const int d = tid >> 2, ch = tid & 3; *(u32x4*)(dst + (size_t)d * Lk + ch * 8) = *(const LAS u32x4*)(VTAS + d * 32 + ch * 8); }
    }
    __syncthreads();
}

DI float max3f(float a, float b, float c) { float r; asm("v_max3_f32 %0, %1, %2, %3" : "=v"(r) : "v"(a), "v"(b), "v"(c)); return r; }
#define SBAR() __builtin_amdgcn_sched_barrier(0)
template <int DQK, bool HN, int ABL>
DI void att_step(f32x16& C0, f32x16& C1, f32x16& N0, f32x16& N1, f32x16& o0, f32x16& o1, f32x16& negm, float& mref, float& lsum,
                 const bf16x8 (&qf)[DQK / 16], const LAS unsigned char* kb, const LAS unsigned char* vb) {
    constexpr int ND = DQK / 16, NQ = 2 * ND, KP = DQK * 2 + 16, VP = 144, NI = NQ > 8 ? NQ : 8;
    constexpr int AH = 4;
    bf16x8 kf[NQ];
    if (HN) {
#pragma unroll
        for (int i = 0; i < AH; ++i) kf[i] = *(const LAS bf16x8*)(kb + (i & 1) * 32 * KP + (i >> 1) * 32);
    }
    SBAR();
    u32x4 pw[4];
#pragma unroll
    for (int i = 0; i < NI; ++i) {
        if (HN && i < NQ) { if (i & 1) N1 = MFMA32(kf[i], qf[i >> 1], (i < 2) ? negm : N1); else N0 = MFMA32(kf[i], qf[i >> 1], (i < 2) ? negm : N0); }
        if (HN && i + AH < NQ) kf[i + AH] = *(const LAS bf16x8*)(kb + ((i + AH) & 1) * 32 * KP + ((i + AH) >> 1) * 32);
        if (i < 8) {
#pragma unroll
            for (int e = 0; e < 4; ++e) { const int idx = 4 * (i & 3) + e; if (ABL & 1) { if (i < 4) C0[idx] = fmaf(C0[idx], 0.001f, 1.f); else C1[idx] = fmaf(C1[idx], 0.001f, 1.f); } else { if (i < 4) C0[idx] = __builtin_amdgcn_exp2f(C0[idx]); else C1[idx] = __builtin_amdgcn_exp2f(C1[idx]); } }
            if (i & 1) { const int k = i >> 1, b8 = 8 * (k & 1);
                if (k < 2) { pw[k].x = pk2(C0[b8], C0[b8 + 1]); pw[k].y = pk2(C0[b8 + 2], C0[b8 + 3]); pw[k].z = pk2(C0[b8 + 4], C0[b8 + 5]); pw[k].w = pk2(C0[b8 + 6], C0[b8 + 7]); }
                else { pw[k].x = pk2(C1[b8], C1[b8 + 1]); pw[k].y = pk2(C1[b8 + 2], C1[b8 + 3]); pw[k].z = pk2(C1[b8 + 4], C1[b8 + 5]); pw[k].w = pk2(C1[b8 + 6], C1[b8 + 7]); } }
        }
        SBAR();
    }
    bf16x8 vf[8];
#pragma unroll
    for (int i = 0; i < AH; ++i) vf[i] = *(const LAS bf16x8*)(vb + (i & 1) * 32 * VP + (i >> 1) * 32);
    SBAR();
    float ps = 0.f, mx = -3.0e38f;
#pragma unroll
    for (int i = 0; i < 8; ++i) {
        if (i & 1) o1 = MFMA32(vf[i], __builtin_bit_cast(bf16x8, pw[i >> 1]), o1); else o0 = MFMA32(vf[i], __builtin_bit_cast(bf16x8, pw[i >> 1]), o0);
        if (i + AH < 8) vf[i + AH] = *(const LAS bf16x8*)(vb + ((i + AH) & 1) * 32 * VP + ((i + AH) >> 1) * 32);
        if (HN && i == 0) asm volatile("s_nop 11" : "+v"(N0), "+v"(N1));
#pragma unroll
        for (int e = 0; e < 4; ++e) { const int idx = 4 * (i & 3) + e; ps += (i < 4) ? C0[idx] : C1[idx]; }
        if (HN && !(ABL & 8)) { mx = max3f(mx, N0[2 * i], N1[2 * i]); mx = max3f(mx, N0[2 * i + 1], N1[2 * i + 1]); }
        SBAR();
    }
    lsum += ps;
    if (HN && !(ABL & 8)) {
        { auto rr = __builtin_amdgcn_permlane32_swap(__float_as_uint(mx), __float_as_uint(mx), false, false); mx = fmaxf(__uint_as_float(rr[0]), __uint_as_float(rr[1])); }
        if (__any(mx > 8.f)) { const float dl = fmaxf(mx, 0.f); mref += dl; const float f = __builtin_amdgcn_exp2f(-dl);
#pragma unroll
            for (int i = 0; i < 16; ++i) { N0[i] -= dl; N1[i] -= dl; negm[i] = -mref; o0[i] *= f; o1[i] *= f; }
            lsum *= f; }
    }
}

template <int DQK, int ABL>
DI void attn_unit(LAS unsigned char* lds, const bf16* Q, int qpitch, const bf16* K, int kpitch, const bf16* VT, int Lk, bf16* O, int tid_in) {
    constexpr int ND = DQK / 16, NQ = 2 * ND, KP = DQK * 2 + 16, VP = 144, NCH = DQK / 8, KBUF = 64 * KP, VBUF = 64 * VP;
    LAS unsigned char* Kl = lds; LAS unsigned char* Vl = lds + 2 * KBUF;
    int tid = tid_in; asm volatile("" : "+v"(tid));
    const int lane = tid & 63, w = __builtin_amdgcn_readfirstlane(tid >> 6);
    const int r = lane & 31, hh = lane >> 5;
    const int kr0 = tid / NCH, kc0 = tid % NCH, kr1 = (tid + 512) / NCH, kc1 = (tid + 512) % NCH;
    const bool k2 = (DQK == 96) && (tid < 256);
    const int vd = tid >> 3, vc = tid & 7;
    u32x4 kreg0, kreg1 = (u32x4){0u, 0u, 0u, 0u}, vreg;
#define ATT_LOADK(tile) do { if (ABL & 2) break; kreg0 = *(const u32x4*)(K + (size_t)((tile) * 64 + kr0) * kpitch + kc0 * 8); \
        if (k2) kreg1 = *(const u32x4*)(K + (size_t)((tile) * 64 + kr1) * kpitch + kc1 * 8); } while (0)
#define ATT_LOADV(tile) do { if (ABL & 2) break; vreg = *(const u32x4*)(VT + (size_t)vd * Lk + (tile) * 64 + vc * 8); } while (0)
#define ATT_STOREK(buf) do { if (ABL & 2) break; *(LAS u32x4*)(Kl + (buf) * KBUF + kr0 * KP + kc0 * 16) = kreg0; \
        if (k2) *(LAS u32x4*)(Kl + (buf) * KBUF + kr1 * KP + kc1 * 16) = kreg1; } while (0)
#define ATT_STOREV(buf) do { if (ABL & 2) break; *(LAS u32x4*)(Vl + (buf) * VBUF + vd * VP + vc * 16) = vreg; } while (0)
    bf16x8 qf[ND];
#pragma unroll
    for (int d0 = 0; d0 < ND; ++d0) qf[d0] = *(const bf16x8*)(Q + (size_t)(w * 32 + r) * qpitch + d0 * 16 + hh * 8);
    const int NT = Lk >> 6;
    ATT_LOADK(0); ATT_STOREK(0); ATT_LOADV(0); ATT_STOREV(0); ATT_LOADK(1); ATT_STOREK(1);
    __syncthreads();
    const LAS unsigned char* kbase = Kl + r * KP + hh * 16;
    const LAS unsigned char* vbase = Vl + r * VP + hh * 16;
    f32x16 A0, A1, B0, B1, o0, o1, negm;
#pragma unroll
    for (int i = 0; i < 16; ++i) { A0[i] = 0.f; A1[i] = 0.f; B0[i] = 0.f; B1[i] = 0.f; o0[i] = 0.f; o1[i] = 0.f; }
    {
        bf16x8 kf[NQ];
#pragma unroll
        for (int i = 0; i < NQ; ++i) kf[i] = *(const LAS bf16x8*)(kbase + (i & 1) * 32 * KP + (i >> 1) * 32);
#pragma unroll
        for (int i = 0; i < NQ; ++i) { if (i & 1) A1 = MFMA32(kf[i], qf[i >> 1], A1); else A0 = MFMA32(kf[i], qf[i >> 1], A0); }
    }
    float mref = fmaxf(A0[0], A1[0]);
#pragma unroll
    for (int i = 1; i < 16; ++i) mref = fmaxf(mref, fmaxf(A0[i], A1[i]));
    mref = fmaxf(mref, __shfl_xor(mref, 32));
#pragma unroll
    for (int i = 0; i < 16; ++i) { A0[i] -= mref; A1[i] -= mref; negm[i] = -mref; }
    float lsum = 0.f;
#pragma unroll 1
    for (int t = 0; t + 2 < NT; t += 2) {
        ATT_LOADK(t + 2); ATT_LOADV(t + 1);
        att_step<DQK, true, ABL>(A0, A1, B0, B1, o0, o1, negm, mref, lsum, qf, kbase + KBUF, vbase);
        ATT_STOREK(0); ATT_STOREV(1); if (!(ABL & 4)) __syncthreads();
        ATT_LOADK(t + 3); ATT_LOADV(t + 2);
        att_step<DQK, true, ABL>(B0, B1, A0, A1, o0, o1, negm, mref, lsum, qf, kbase, vbase + VBUF);
        ATT_STOREK(1); ATT_STOREV(0); if (!(ABL & 4)) __syncthreads();
    }
    ATT_LOADV(NT - 1);
    att_step<DQK, true, ABL>(A0, A1, B0, B1, o0, o1, negm, mref, lsum, qf, kbase + KBUF, vbase);
    ATT_STOREV(1); __syncthreads();
    att_step<DQK, false, ABL>(B0, B1, A0, A1, o0, o1, negm, mref, lsum, qf, kbase, vbase + VBUF);
    __syncthreads();
#undef ATT_LOADK
#undef ATT_LOADV
#undef ATT_STOREK
#undef ATT_STOREV
    lsum += __shfl_xor(lsum, 32);
    const float inv = 1.f / lsum;
    bf16* op = O + (size_t)(w * 32 + r) * 1024;
    if (!(ABL & 16) || lsum == 1.2345e-30f)
#pragma unroll
    for (int g4 = 0; g4 < 4; ++g4) { const int d = 8 * g4 + 4 * hh; u32x2 x0, x1;
        x0.x = pk2(o0[4 * g4] * inv, o0[4 * g4 + 1] * inv); x0.y = pk2(o0[4 * g4 + 2] * inv, o0[4 * g4 + 3] * inv);
        x1.x = pk2(o1[4 * g4] * inv, o1[4 * g4 + 1] * inv); x1.y = pk2(o1[4 * g4 + 2] * inv, o1[4 * g4 + 3] * inv);
        *(u32x2*)(op + d) = x0; *(u32x2*)(op + 32 + d) = x1; }
}

template <bool WY>
DI void s5_run(LAS float* wl, const bf16* U, float* Y, int L, int dir, int c_lo, int c_hi, const bf16x8 (&bfr)[4], const bf16x8 (&cfr)[4], float ar, float ai, float& sre, float& sim, int lane) {
    const int pl = lane & 31, hh = lane >> 5, n16 = lane & 15, kq = lane >> 4;
    f32x16 zero16;
#pragma unroll
    for (int i = 0; i < 16; ++i) zero16[i] = 0.f;
    bf16x8 uf_n0, uf_n1;
    { const int t0 = dir ? (L - 1 - c_lo - pl) : (c_lo + pl); uf_n0 = *(const bf16x8*)(U + (size_t)t0 * 256 + 8 * hh);
      const int t1 = dir ? (L - 1 - c_lo - 32 - pl) : (c_lo + 32 + pl); uf_n1 = *(const bf16x8*)(U + (size_t)t1 * 256 + 8 * hh); }
#pragma unroll 1
    for (int c0 = c_lo; c0 < c_hi; c0 += 32) {
        const bf16x8 uf = uf_n0; uf_n0 = uf_n1;
        if (c0 + 64 < c_hi) { const int t2 = dir ? (L - 1 - c0 - 64 - pl) : (c0 + 64 + pl); uf_n1 = *(const bf16x8*)(U + (size_t)t2 * 256 + 8 * hh); }
#pragma unroll
        for (int blk = 0; blk < 4; ++blk) { const f32x16 d = MFMA32(uf, bfr[blk], zero16);
#pragma unroll
            for (int i = 0; i < 16; ++i) wl[crow(i, hh) * 132 + blk * 32 + pl] = d[i]; }
        LDS_FENCE();
        {
            float br_[32], bi_[32];
#pragma unroll
            for (int tau = 0; tau < 32; ++tau) { br_[tau] = wl[tau * 132 + lane]; bi_[tau] = wl[tau * 132 + 64 + lane]; }
#pragma unroll
            for (int tau = 0; tau < 32; ++tau) { const float n_r = fmaf(ar, sre, fmaf(-ai, sim, br_[tau])), n_i = fmaf(ar, sim, fmaf(ai, sre, bi_[tau])); sre = n_r; sim = n_i; br_[tau] = n_r; bi_[tau] = n_i; }
            if (WY) {
#pragma unroll
                for (int tau = 0; tau < 32; ++tau) { wl[tau * 132 + lane] = br_[tau]; wl[tau * 132 + 64 + lane] = bi_[tau]; } }
        }
        LDS_FENCE();
        if (WY) {
#pragma unroll
            for (int rb = 0; rb < 2; ++rb) { f32x4 acc = (f32x4){0.f, 0.f, 0.f, 0.f};
#pragma unroll
                for (int ks = 0; ks < 4; ++ks) { const LAS float* sp = wl + (rb * 16 + n16) * 132 + 32 * ks + 8 * kq; const f32x4 s0 = *(const LAS f32x4*)sp, s1 = *(const LAS f32x4*)(sp + 4);
                    u32x4 pw; pw.x = pk2(s0.x, s0.y); pw.y = pk2(s0.z, s0.w); pw.z = pk2(s1.x, s1.y); pw.w = pk2(s1.z, s1.w);
                    acc = MFMA16(__builtin_bit_cast(bf16x8, pw), cfr[ks], acc); }
#pragma unroll
                for (int i = 0; i < 4; ++i) { const int tau = rb * 16 + 4 * kq + i; const int tt = dir ? (L - 1 - c0 - tau) : (c0 + tau); Y[(size_t)tt * 256 + n16] = acc[i]; } }
            LDS_FENCE();
        }
    }
}
template <bool SPLIT>
DI void s5_task(const Args& a, LAS float* wl, LAS float* xl, int l, int seq, int g, int dir, int lane, int w) {
    const int L = seq < 16 ? 256 : 4096; const int mbase = seq < 16 ? seq * 256 : MP + (seq - 16) * 4096;
    const int pidx = (l * 2 + dir) * 16 + g;
    const float lre = a.in[22][pidx * 64 + lane], lim = a.in[23][pidx * 64 + lane], dt = expf(a.in[24][pidx]);
    const float x = lre * dt, y = lim * dt, ex = expf(x); float sy, cy; sincos_acc(y, sy, cy);
    const float ar = ex * cy, ai = ex * sy;
    float shh, chh; sincos_acc(0.5f * y, shh, chh);
    const float nr = expm1_acc(x) * cy - 2.f * shh * shh, ni = ex * sy, den = lre * lre + lim * lim;
    const float cre = (nr * lre + ni * lim) / den, cim = (ni * lre - nr * lim) / den;
    const int pl = lane & 31, hh = lane >> 5, n16 = lane & 15, kq = lane >> 4;
    bf16x8 bfr[4];
#pragma unroll
    for (int blk = 0; blk < 4; ++blk) { const int ps = (blk & 1) * 32 + pl; const float cr = __shfl(cre, ps), ci = __shfl(cim, ps);
        const float* br = a.in[25] + ((size_t)pidx * 64 + ps) * 16 + 8 * hh; const float* bi = a.in[26] + ((size_t)pidx * 64 + ps) * 16 + 8 * hh;
        const f32x4 r0 = *(const f32x4*)br, r1 = *(const f32x4*)(br + 4), i0 = *(const f32x4*)bi, i1 = *(const f32x4*)(bi + 4);
        f32x4 v0, v1; if (blk < 2) { v0 = r0 * cr - i0 * ci; v1 = r1 * cr - i1 * ci; } else { v0 = i0 * cr + r0 * ci; v1 = i1 * cr + r1 * ci; }
        u32x4 pw; pw.x = pk2(v0.x, v0.y); pw.y = pk2(v0.z, v0.w); pw.z = pk2(v1.x, v1.y); pw.w = pk2(v1.z, v1.w); bfr[blk] = __builtin_bit_cast(bf16x8, pw); }
    bf16x8 cfr[4];
#pragma unroll
    for (int ks = 0; ks < 4; ++ks) { const int k0 = 32 * ks + 8 * kq; const float* src = (k0 < 64) ? a.in[27] + ((size_t)pidx * 16 + n16) * 64 + k0 : a.in[28] + ((size_t)pidx * 16 + n16) * 64 + (k0 - 64);
        const float sg = (k0 < 64) ? 1.f : -1.f; const f32x4 c0 = *(const f32x4*)src * sg, c1 = *(const f32x4*)(src + 4) * sg;
        u32x4 pw; pw.x = pk2(c0.x, c0.y); pw.y = pk2(c0.z, c0.w); pw.z = pk2(c1.x, c1.y); pw.w = pk2(c1.z, c1.w); cfr[ks] = __builtin_bit_cast(bf16x8, pw); }
    float sre = 0.f, sim = 0.f;
    if (seq >= 16) { const size_t si = ((size_t)(((seq - 16) * 4 + l) * 2 + dir) * 16 + g) * 64 + lane; sre = a.in[6][si]; sim = a.in[7][si]; }
    const bf16* U = (const bf16*)(a.ws + WS_UU) + (size_t)mbase * 256 + g * 16;
    float* Y = (float*)(a.ws + WS_H) + (size_t)dir * MT * 256 + (size_t)mbase * 256 + g * 16;
    if (!SPLIT) {
        s5_run<true>(wl, U, Y, L, dir, 0, L, bfr, cfr, ar, ai, sre, sim, lane);
        if (seq < 16) { const size_t so = ((size_t)((seq * 4 + l) * 2 + dir) * 16 + g) * 64 + lane; a.out[O_SRE + so] = sre; a.out[O_SIM + so] = sim; }
    } else {
        const int c_lo = w * 512, c_hi = c_lo + 512;
        float er = 0.f, ei = 0.f;
        if (w < 7) s5_run<false>(wl, U, Y, L, dir, c_lo, c_hi, bfr, cfr, ar, ai, er, ei, lane);
        xl[w * 128 + lane] = er; xl[w * 128 + 64 + lane] = ei;
        __syncthreads();
        float pr = ar, pi = ai;
#pragma unroll
        for (int q = 0; q < 9; ++q) { const float t_r = pr * pr - pi * pi, t_i = 2.f * pr * pi; pr = t_r; pi = t_i; }
        for (int j = 0; j < w; ++j) { const float e_r = xl[j * 128 + lane], e_i = xl[j * 128 + 64 + lane]; const float n_r = fmaf(pr, sre, fmaf(-pi, sim, e_r)), n_i = fmaf(pr, sim, fmaf(pi, sre, e_i)); sre = n_r; sim = n_i; }
        s5_run<true>(wl, U, Y, L, dir, c_lo, c_hi, bfr, cfr, ar, ai, sre, sim, lane);
        __syncthreads();
    }
}

DI void glu_item(const Args& a, LAS unsigned char* lds, int l, int item, int tid, int lane, int w) {
    const int m0 = item * 32;
    LAS bf16* YG = (LAS bf16*)lds;
    LAS float* YF32 = (LAS float*)(lds + 16896);
    const bf16* UU = (const bf16*)(a.ws + WS_UU); const float* YF = (const float*)(a.ws + WS_H); const float* YB = YF + (size_t)MT * 256;
    bf16* MIX = (bf16*)(a.ws + WS_PROJ);
    const int row = tid >> 4, c0 = (tid & 15) * 16; const size_t gro = (size_t)(m0 + row) * 256 + c0;
#pragma unroll
    for (int q = 0; q < 4; ++q) { const u32x2 ur = *(const u32x2*)(UU + gro + q * 4); const f32x4 yf = *(const f32x4*)(YF + gro + q * 4), yb = *(const f32x4*)(YB + gro + q * 4), dd = *(const f32x4*)(a.in[29] + l * 256 + c0 + q * 4);
        f32x4 y; y.x = dd.x * bflo(ur.x) + yf.x + yb.x; y.y = dd.y * bfhi(ur.x) + yf.y + yb.y; y.z = dd.z * bflo(ur.y) + yf.z + yb.z; y.w = dd.w * bfhi(ur.y) + yf.w + yb.w;
#pragma unroll
        for (int e = 0; e < 4; ++e) { const float v = y[e]; const float z = 0.7978845608028654f * (v + 0.044715f * v * v * v); const float th = 1.f - 2.f * __builtin_amdgcn_rcpf(1.f + __expf(2.f * z)); y[e] = 0.5f * v * (1.f + th); }
        *(LAS f32x4*)(YF32 + row * 260 + c0 + q * 4) = y; u32x2 o; o.x = pk2(y.x, y.y); o.y = pk2(y.z, y.w); *(LAS u32x2*)(YG + row * 264 + c0 + q * 4) = o; }
    __syncthreads();
    const int n16 = lane & 15, kq = lane >> 4;
    { const bf16* W = (const bf16*)(a.ws + WS_WGLU) + (size_t)l * 256 * 256 + (size_t)(w * 32 + n16) * 256 + 8 * kq;
      f32x4 acc[2][2];
#pragma unroll
      for (int c = 0; c < 2; ++c) { acc[c][0] = (f32x4){0.f, 0.f, 0.f, 0.f}; acc[c][1] = (f32x4){0.f, 0.f, 0.f, 0.f}; }
      small_gemm<2, 8, 264, 256>(YG, W, item + w, acc, n16, kq);
#pragma unroll
      for (int c = 0; c < 2; ++c) { const int col = w * 32 + c * 16 + n16; const float bg = a.in[31][l * 256 + col];
#pragma unroll
          for (int rb = 0; rb < 2; ++rb)
#pragma unroll
              for (int i = 0; i < 4; ++i) { const int rw = 16 * rb + 4 * kq + i; const float z = acc[c][rb][i] + bg; const float yv = YF32[rw * 260 + col]; YF32[rw * 260 + col] = yv * __builtin_amdgcn_rcpf(1.f + __expf(-z)); } } }
    __syncthreads();
    { u32x4 o0, o1; const LAS float* sp = YF32 + row * 260 + c0; const f32x4 a0 = *(const LAS f32x4*)sp, a1 = *(const LAS f32x4*)(sp + 4), a2 = *(const LAS f32x4*)(sp + 8), a3 = *(const LAS f32x4*)(sp + 12);
      o0.x = pk2(a0.x, a0.y); o0.y = pk2(a0.z, a0.w); o0.z = pk2(a1.x, a1.y); o0.w = pk2(a1.z, a1.w); o1.x = pk2(a2.x, a2.y); o1.y = pk2(a2.z, a2.w); o1.z = pk2(a3.x, a3.y); o1.w = pk2(a3.z, a3.w);
      bf16* dst = MIX + (size_t)(m0 + row) * 1024 + 768 + c0; *(u32x4*)dst = o0; *(u32x4*)(dst + 8) = o1; }
    __syncthreads();
}

typedef __attribute__((address_space(1))) unsigned gu32;
#define XB_TMO      128
#define XB_XCNT(j)  (256  + 64 * (j))
#define XB_XSUB(j)  (1280 + 64 * (j))
#define XB_XGEN(j)  (2304 + 64 * (j))
#define XB_TOP      3328
#define XB_TOPGEN   3392
#define XCD_BAR_WORDS 3456
#define XB_SPIN_CAP (1u << 18)

__device__ __forceinline__ unsigned xb_ld(unsigned* p)              { return __hip_atomic_load(p, __ATOMIC_RELAXED, __HIP_MEMORY_SCOPE_AGENT); }
__device__ __forceinline__ unsigned xb_add(unsigned* p, unsigned v) { return __hip_atomic_fetch_add(p, v, __ATOMIC_RELAXED, __HIP_MEMORY_SCOPE_AGENT); }
__device__ __forceinline__ unsigned xb_xcc_id() { return (unsigned)__builtin_amdgcn_s_getreg((3 << 11) | 20) & 0xFu; }
#define XB_SPIN(cond, bar) do { unsigned _sp = 0; while (cond) { __builtin_amdgcn_s_sleep(1); \
    if ((++_sp & 255u) == 0u) { if (xb_ld(&(bar)[XB_TMO])) break; if (_sp > XB_SPIN_CAP) { atomicAdd(&(bar)[XB_TMO], 1u); break; } } } } while (0)

struct XcdBarrier {
    unsigned* bar; unsigned x;
    volatile LAS unsigned* st;
};

__device__ __forceinline__ XcdBarrier xcd_barrier_post(unsigned* bar, volatile LAS unsigned* st) {
    XcdBarrier b; b.bar = bar; b.x = xb_xcc_id(); b.st = st;
    if (threadIdx.x == 0) (void)xb_add(&bar[XB_XCNT(b.x)], 1u);
    return b;
}
__device__ __forceinline__ void xcd_barrier_complete(unsigned* bar, unsigned x, unsigned& nloc, unsigned& nx) {
    const unsigned G = gridDim.x * gridDim.y * gridDim.z;
    unsigned sum, cnt, mine, sp = 0u;
    for (;;) {
        sum = 0u; cnt = 0u; mine = 0u;
#pragma unroll
        for (unsigned j = 0; j < 16; ++j) { const unsigned c = xb_ld(&bar[XB_XCNT(j)]); sum += c; cnt += (c > 0u) ? 1u : 0u; mine = (j == x) ? c : mine; }
        if (sum == G) break;
        __builtin_amdgcn_s_sleep(1);
        if ((++sp & 255u) == 0u) { if (xb_ld(&bar[XB_TMO])) break; if (sp > XB_SPIN_CAP) { atomicAdd(&bar[XB_TMO], 1u); break; } }
    }
    nloc = mine > 0u ? mine : 1u; nx = cnt > 0u ? cnt : 1u;
}

__device__ __forceinline__ void xcd_barrier(const XcdBarrier& b) {
    asm volatile("s_waitcnt vmcnt(0)" ::: "memory");
    __syncthreads();
    if (threadIdx.x == 0) {
        unsigned* bar = b.bar;
        __builtin_amdgcn_s_waitcnt(0);
        unsigned nloc = b.st[0], nx = b.st[1];
        if (nloc == 0u) { xcd_barrier_complete(bar, b.x, nloc, nx); b.st[0] = nloc; b.st[1] = nx; }
        const unsigned old = xb_add(&bar[XB_XSUB(b.x)], 1u);
        const unsigned gen = old / nloc;
        if (old + 1u == (gen + 1u) * nloc) {
            __builtin_amdgcn_fence(__ATOMIC_RELEASE, "agent");
            asm volatile("s_waitcnt vmcnt(0)" ::: "memory");
            const unsigned og = xb_add(&bar[XB_TOP], 1u);
            const unsigned tg = og / nx;
            if (og + 1u == (tg + 1u) * nx) xb_add(&bar[XB_TOPGEN], 1u);
            else XB_SPIN(xb_ld(&bar[XB_TOPGEN]) == tg, bar);
            __builtin_amdgcn_fence(__ATOMIC_ACQUIRE, "agent");
            xb_add(&bar[XB_XGEN(b.x)], 1u);
            asm volatile("s_waitcnt vmcnt(0)" ::: "memory");
        } else {
            XB_SPIN(xb_ld(&bar[XB_XGEN(b.x)]) == gen, bar);
            __builtin_amdgcn_fence(__ATOMIC_ACQUIRE, "agent");
            asm volatile("s_waitcnt vmcnt(0)" ::: "memory");
        }
    }
    __syncthreads();
}

#define ATT_UNITS(ABLV) \
            for (int uu = vcu; uu < 256 + 1536; uu += G) { \
                int seq, h, m0, Lk; bool mla; size_t kr0; \
                if (uu < 256) { const int s = uu; if ((s & 3) == 0) continue; const int pu = (s >> 2) * 3 + (s & 3) - 1; seq = pu / 12; const int hx = pu % 12; mla = hx >= 6; h = mla ? hx - 6 : hx; m0 = seq * 256; Lk = 256; kr0 = (size_t)m0; } \
                else { const int u = uu - 256; const int pass = u >> 8, c = u & 255, idx = (pass >> 1) * 256 + c; const int b = idx / 96; h = (idx % 96) >> 4; const int qb = idx & 15; \
                       seq = 16 + b; mla = (pass & 1) != 0; m0 = MP + b * 4096 + qb * 256; Lk = LKS; kr0 = (size_t)MP + (size_t)b * LKS; } \
                if (!mla) attn_unit<64, ABLV>(lds, QA + (size_t)m0 * 384 + h * 64, 384, KA + kr0 * 128 + (h / 3) * 64, 128, VTA + vtbase(seq, 128) + (size_t)(h / 3) * 64 * Lk, Lk, MIX + (size_t)m0 * 1024 + h * 64, tid); \
                else attn_unit<96, ABLV>(lds, QB + (size_t)m0 * 576 + h * 96, 576, KB + kr0 * 576 + h * 96, 576, VTB + vtbase(seq, 384) + (size_t)h * 64 * Lk, Lk, MIX + (size_t)m0 * 1024 + 384 + h * 64, tid); \
            }
__global__ void __launch_bounds__(512, 2) mega(Args a) {
    extern __shared__ __attribute__((aligned(16))) unsigned char lds_raw[];
    LAS unsigned char* lds = (LAS unsigned char*)lds_raw;
    cg::grid_group grid = cg::this_grid();
    const int G = gridDim.x, bx = blockIdx.x;
#define LAUNDER_TID int tid = threadIdx.x; asm volatile("" : "+v"(tid)); const int lane = tid & 63, w = __builtin_amdgcn_readfirstlane(tid >> 6); const int gw = vcu * 8 + w
    const int vcu = (G % 8 == 0) ? (bx % 8) * (G / 8) + bx / 8 : bx;
    const int ngw = G * 8;
    int ph = 0;
    volatile LAS unsigned* bar_st = (volatile LAS unsigned*)(lds + LDS_BYTES - 64);
    if (threadIdx.x < 2) bar_st[threadIdx.x] = 0u;
    __syncthreads();
    XcdBarrier xbar = xcd_barrier_post((unsigned*)(a.ws + WS_BAR), bar_st);
#ifndef PMASK
#define PMASK 0xFFFF
#endif
#define PH_ON (a.ph_lo <= ph && ph < a.ph_hi)
#define PM(b) ((PMASK >> (b)) & 1)
#ifndef REPMASK
#define REPMASK 0
#endif
#define REPS(b) (((REPMASK >> (b)) & 1) ? 2 : 1)
#define PH_END do { if (a.ph_lo <= ph && ph + 1 < a.ph_hi) { if (ph == 0) grid.sync(); else xcd_barrier(xbar); } ++ph; } while (0)
    float* X = a.out;
    bf16* H = (bf16*)(a.ws + WS_H);
    const float* MOD = (const float*)(a.ws + WS_MOD);

    if (PM(0) && PH_ON) for (int rep = 0; rep < REPS(0); ++rep) { LAUNDER_TID;
        p0_convert(a, lds, gw, ngw, w, lane);
        __syncthreads();
        for (int it = bx; it < 768; it += G) ada_partial_item(a, lds, it, tid);
    }
    PH_END;
    if (PM(1) && PH_ON) for (int rep = 0; rep < REPS(1); ++rep) { LAUNDER_TID;
        const float* P = (const float*)(a.ws + WS_MODP); float* Mo = (float*)(a.ws + WS_MOD);
        for (int i = bx * 512 + tid; i < NLAYER * 9 * 6144; i += G * 512) { const int l = i / (9 * 6144), r = i % (9 * 6144), n = r % 6144; float s = a.in[13][l * 6144 + n];
#pragma unroll
            for (int ks = 0; ks < 8; ++ks) s += P[(size_t)(l * 8 + ks) * 9 * 6144 + r];
            Mo[i] = s; }
    }
    PH_END;
    if (PM(2) && PH_ON) for (int rep = 0; rep < REPS(2); ++rep) { LAUNDER_TID; norm_rows(a.in[0], a.in[1], a.in[10], MOD, 0, 1024, H, gw, ngw, lane); }
    PH_END;

#pragma unroll 1
    for (int l = 0; l < NLAYER; ++l) {
        const float* mod_l = MOD + (size_t)l * 9 * 6144;
        if (PM(3) && PH_ON) for (int rep = 0; rep < REPS(3); ++rep) {
            pg8::Gemm g{H, (const bf16*)(a.ws + WS_WIN) + (size_t)l * 1536 * 1024, MT, NINP, 1024}; pg8::StaticOrder S; S.init(MT, NINP, G, bx);
            pg8::EpiBf16<0> E{(bf16*)(a.ws + WS_PROJ), NINP, nullptr, 0, 0, 1.f};
            pg8::gemm_phase<pg8::EpiBf16<0>, pg8::StaticOrder, true, true>(lds, g, S, E);
        }
        PH_END;
        if (PM(4) && PH_ON) for (int rep = 0; rep < REPS(4); ++rep) { LAUNDER_TID;
            post_tables(lds, tid); __syncthreads();
#ifdef PABLX
            for (int it = vcu; it < 1152 + 128; it += G) post_item<PABLX>(a, lds, l, it, tid, lane, w);
#endif
            for (int it = vcu; it < 1152 + 128; it += G) post_item<0>(a, lds, l, it, tid, lane, w);
        }
        PH_END;
        if (PM(5) && PH_ON) for (int rep = 0; rep < REPS(5); ++rep) { LAUNDER_TID;
            const bf16* QA = (const bf16*)(a.ws + WS_QA); const bf16* QB = (const bf16*)(a.ws + WS_QB); const bf16* KA = (const bf16*)(a.ws + WS_KA); const bf16* KB = (const bf16*)(a.ws + WS_KB);
            const bf16* VTA = (const bf16*)(a.ws + WS_VTA); const bf16* VTB = (const bf16*)(a.ws + WS_VTB); bf16* MIX = (bf16*)(a.ws + WS_PROJ);
            for (int s = vcu; s < 256; s += G) {
                s5_task<true>(a, (LAS float*)(lds + w * 16896), (LAS float*)(lds + 135168), l, 16 + (s >> 5), (s & 31) >> 1, s & 1, lane, w);
                if (w < 2) { const int id = s * 2 + w; s5_task<false>(a, (LAS float*)(lds + w * 16896), (LAS float*)(lds + 135168), l, id >> 5, (id & 31) >> 1, id & 1, lane, w); }
            }
            __syncthreads();
            ATT_UNITS(0)
#ifdef ABLX
            __syncthreads();
            ATT_UNITS(ABLX)
#endif
        }
        PH_END;
        if (PM(6) && PH_ON) for (int rep = 0; rep < REPS(6); ++rep) { LAUNDER_TID; for (int it = vcu; it < 1152; it += G) glu_item(a, lds, l, it, tid, lane, w); }
        PH_END;
        if (PM(7) && PH_ON) {
            pg8::Gemm g{(const bf16*)(a.ws + WS_PROJ), (const bf16*)(a.ws + WS_WOUT) + (size_t)l * 1024 * 1024, MT, 1024, 1024}; pg8::StaticOrder S; S.init(MT, 1024, G, bx);
            EpiRes E{l == 0 ? a.in[0] : X, l == 0 ? a.in[1] : X + (size_t)MP * 1024, X, mod_l + 2048};
            pg8::gemm_phase<EpiRes, pg8::StaticOrder, true, true>(lds, g, S, E);
        }
        PH_END;
        if (PM(8) && PH_ON) for (int rep = 0; rep < REPS(8); ++rep) { LAUNDER_TID; norm_rows(X, X + (size_t)MP * 1024, a.in[11] + l * 1024, mod_l, 3072, 4096, H, gw, ngw, lane); }
        PH_END;
        if (PM(9) && PH_ON) for (int rep = 0; rep < REPS(9); ++rep) {
            pg8::Gemm g{H, (const bf16*)(a.ws + WS_WF1) + (size_t)l * 5632 * 1024, MT, NF1, 1024}; pg8::StaticOrder S; S.init(MT, NF1, G, bx);
            EpiSwiglu E{(bf16*)(a.ws + WS_HDN)};
            pg8::gemm_phase<EpiSwiglu, pg8::StaticOrder, true, true>(lds, g, S, E);
        }
        PH_END;
        if (PM(10) && PH_ON) {
            pg8::Gemm g{(const bf16*)(a.ws + WS_HDN), (const bf16*)(a.ws + WS_WF2) + (size_t)l * 1024 * 2816, MT, 1024, DFF}; pg8::StaticOrder S; S.init(MT, 1024, G, bx);
            EpiRes E{X, X + (size_t)MP * 1024, X, mod_l + 5120};
            pg8::gemm_phase<EpiRes, pg8::StaticOrder, true, true>(lds, g, S, E);
        }
        PH_END;
        if (PM(11) && PH_ON) { LAUNDER_TID;
            if (l + 1 < NLAYER) norm_rows(X, X + (size_t)MP * 1024, a.in[10] + (l + 1) * 1024, mod_l + 9 * 6144, 0, 1024, H, gw, ngw, lane);
            else final_norm_rows(X, a.in[35], gw, ngw, lane);
        }
        PH_END;
    }
}

extern "C" void kernel_launch(void* const* d_in, const int* in_sizes, int n_in, void* d_out, int out_size, void* d_ws, size_t ws_size, hipStream_t stream) {
    static int grid = 0;
    if (grid == 0) {
        if (n_in != 36 || ws_size < WS_TOTAL) { fprintf(stderr, "kernel_launch: unexpected n_in %d / ws %zu (need %zu)\n", n_in, ws_size, (size_t)WS_TOTAL); grid = -1; return; }
        int dev = 0, cus = 0, per_cu = 0;
        hipGetDevice(&dev); hipDeviceGetAttribute(&cus, hipDeviceAttributeMultiprocessorCount, dev);
        if (hipFuncSetAttribute((const void*)mega, hipFuncAttributeMaxDynamicSharedMemorySize, LDS_BYTES) != hipSuccess) fprintf(stderr, "kernel_launch: hipFuncSetAttribute failed\n");
        if (hipOccupancyMaxActiveBlocksPerMultiprocessor(&per_cu, (const void*)mega, 512, LDS_BYTES) != hipSuccess || per_cu < 1) { fprintf(stderr, "kernel_launch: occupancy query says %d\n", per_cu); per_cu = 1; }
        (void)hipGetLastError();
        grid = cus;
    }
    if (grid < 0) return;
    Args a{};
    for (int i = 0; i < 36; ++i) a.in[i] = (const float*)d_in[i];
    a.out = (float*)d_out; a.ws = (unsigned char*)d_ws;
#if defined(MK_MULTI)
    for (int p = 0; p < NPHASE; ++p) { a.ph_lo = p; a.ph_hi = p + 1; hipLaunchKernelGGL(mega, dim3(grid), dim3(512), LDS_BYTES, stream, a); }
#else
    a.ph_lo = 0; a.ph_hi = NPHASE;
    if (hipMemsetAsync((char*)d_ws + WS_BAR, 0, 16384, stream) != hipSuccess) fprintf(stderr, "kernel_launch: memset failed\n");
    void* args[] = {&a};
    hipError_t e = hipLaunchCooperativeKernel((const void*)mega, dim3(grid), dim3(512), args, LDS_BYTES, stream);
    if (e != hipSuccess) fprintf(stderr, "kernel_launch: cooperative launch failed: %s (grid %d)\n", hipGetErrorString(e), grid);
#endif
}
```

```cpp
#define WGM_WIDE 4
#define WGM_NARROW 1
#include <hip/hip_runtime.h>
#include <hip/hip_cooperative_groups.h>
#include <cstdio>
#include <cstdint>
namespace cg = cooperative_groups;
namespace pg8 {
#define PG8_LAS __attribute__((address_space(3)))
typedef unsigned short bf16_t;
typedef short bf16x8 __attribute__((ext_vector_type(8)));
typedef float f32x4 __attribute__((ext_vector_type(4)));
typedef unsigned u32x4 __attribute__((ext_vector_type(4)));
constexpr int BM = 256, BK = 64, HALF = 128, HTB = HALF * BK * 2  , STAGE_BYTES = 8 * HTB, NXCD = 8, WGM = 8;
#ifndef WGM_WIDE
#define WGM_WIDE 2
#endif
#ifndef WGM_NARROW
#define WGM_NARROW 8
#endif

__host__ __device__ __forceinline__ int lds_byte(int r, int c) { const int st = (r >> 4) * 2 + (c >> 5), rr = r & 15, cc = c & 31, ob = rr * 64 + cc * 2; return st * 1024 + (ob ^ (((ob >> 9) & 1) << 5)); }
__host__ __device__ __forceinline__ void stage_rc(int b, int& R, int& C) { const int st = b / 1024, sb = b % 1024, swz = sb ^ (((sb >> 9) & 1) << 5); R = (st >> 1) * 16 + swz / 64; C = (st & 1) * 32 + (swz % 64) / 2; }
__host__ __device__ __forceinline__ int perm32(int rho) { const int n = rho >> 4, i = rho & 15; return 8 * (i >> 2) + 4 * n + (i & 3); }

struct Unit { int pm, pn; };
struct Gemm { const bf16_t* A; const bf16_t* Bt; int M, N, K; };

struct StaticOrder {
    int nM, nN, nwg, G, c, wgm;
    __host__ __device__ void init(int M, int N, int G_, int c_) { nM = M / BM; nN = N / BM; nwg = nM * nN; G = G_; c = c_; wgm = (nN >= 16) ? WGM_WIDE : WGM_NARROW; }
    __host__ __device__ bool next(int i, Unit& u) const {
        const long L = (long)i * G + c; if (L >= nwg) return false;
        int wgid = (int)L; { const int q = nwg / NXCD, r = nwg % NXCD, xcd = wgid % NXCD, off = wgid / NXCD; wgid = (xcd < r ? xcd * (q + 1) : r * (q + 1) + (xcd - r) * q) + off; }
        const int nig = wgm * nN, gid = wgid / nig, fm = gid * wgm, gsz = (nM - fm) < wgm ? (nM - fm) : wgm;
        u.pm = fm + ((wgid % nig) % gsz); u.pn = (wgid % nig) / gsz; return true;
    }
    __device__ __forceinline__ void a_ready(const Unit&) const {}
    __device__ __forceinline__ void done(const Unit&) const {}
};

__device__ __forceinline__ unsigned cvt_pk_bf16(float lo, float hi) { unsigned r; asm volatile("v_cvt_pk_bf16_f32 %0, %1, %2" : "=v"(r) : "v"(lo), "v"(hi)); return r; }
typedef float f32x2 __attribute__((ext_vector_type(2)));
__device__ __forceinline__ f32x2 gelu_pk(f32x2 v) {
    const f32x2 av = __builtin_elementwise_abs(v), d = av * 0.2316418882f + 1.0f;
    f32x2 t; t.x = __builtin_amdgcn_rcpf(d.x); t.y = __builtin_amdgcn_rcpf(d.y);
    f32x2 q = t * 0.5307027145f + (-0.7265760135f); q = q * t + 0.7107068705f; q = q * t + (-0.142248368f); q = q * t + 0.127414796f; q = q * t;
    const f32x2 s = (v * v) * (-0.72134752044f);
    f32x2 e; e.x = __builtin_amdgcn_exp2f(s.x); e.y = __builtin_amdgcn_exp2f(s.y);
    const f32x2 m = v * (q * e), r = v - m;
    f32x2 o; o.x = v.x < 0.f ? m.x : r.x; o.y = v.y < 0.f ? m.y : r.y; return o;
}

template <int ACT  > struct EpiBf16 {
    static constexpr bool PERM = true, AFTER_DRAIN = false; static_assert(ACT == 0 || ACT == 1, "EpiBf16: ACT is 0 (none) or 1 (gelu_pk)");
    bf16_t* O; int ldc; const float* bias; int split_cols; size_t split_stride; float scale0;
    __device__ __forceinline__ void operator()(const f32x4 (&acc)[2][2][4][2], const Unit& u, int wr, int wc, int fr, int fq) const {
        const int row0 = u.pm * BM + wr * 64 + fr; int colt = u.pn * BM; bf16_t* base = O;
        float sc = 1.f; if (split_cols) { const int t = colt / split_cols; base += (size_t)t * split_stride; colt -= t * split_cols; if (t == 0) sc = scale0; }
        const int col0 = colt + wc * 32 + 8 * fq, bcol0 = u.pn * BM + wc * 32 + 8 * fq;
        f32x4 bv[2][2];
#pragma unroll
        for (int bj = 0; bj < 2; ++bj)
#pragma unroll
            for (int n = 0; n < 2; ++n) bv[bj][n] = bias ? *(const f32x4*)(bias + bcol0 + bj * HALF + 4 * n) : (f32x4){0.f, 0.f, 0.f, 0.f};
#pragma unroll
        for (int ai = 0; ai < 2; ++ai)
#pragma unroll
            for (int m = 0; m < 4; ++m) { bf16_t* rowp = base + (size_t)(row0 + ai * HALF + m * 16) * ldc + col0;
#pragma unroll
                for (int bj = 0; bj < 2; ++bj) { f32x4 v0 = acc[ai][bj][m][0] + bv[bj][0], v1 = acc[ai][bj][m][1] + bv[bj][1];
                    if (ACT == 1) { f32x2 a = gelu_pk((f32x2){v0[0], v0[1]}), b = gelu_pk((f32x2){v0[2], v0[3]}), c = gelu_pk((f32x2){v1[0], v1[1]}), d = gelu_pk((f32x2){v1[2], v1[3]});
                        v0 = (f32x4){a.x, a.y, b.x, b.y}; v1 = (f32x4){c.x, c.y, d.x, d.y}; }
                    v0 = v0 * sc; v1 = v1 * sc; u32x4 w; w.x = cvt_pk_bf16(v0[0], v0[1]); w.y = cvt_pk_bf16(v0[2], v0[3]); w.z = cvt_pk_bf16(v1[0], v1[1]); w.w = cvt_pk_bf16(v1[2], v1[3]);
                    *(u32x4*)(rowp + bj * HALF) = w; } }
    }
};
template <class Epi, class Sched, bool ALIGN_EPI = false, bool SP2 = false>
__device__ __forceinline__ void gemm_phase(PG8_LAS unsigned char* lds, const Gemm g, const Sched& S, const Epi& E) {
    int tid_ = threadIdx.x; asm volatile("" : "+v"(tid_));
    const int tid = tid_, wid = __builtin_amdgcn_readfirstlane(tid >> 6), lane = tid & 63, wr = wid >> 2, wc = wid & 3, fr = lane & 15, fq = lane >> 4;
    const int K = g.K, nt = K / BK;
    unsigned voffA[2], voffB[2];
#pragma unroll
    for (int i = 0; i < 2; ++i) { int R, C; stage_rc(tid * 16 + i * 8192, R, C); const int Rb = Epi::PERM ? ((R & ~31) + perm32(R & 31)) : R;
        voffA[i] = (unsigned)(R * K + C) * 2u; voffB[i] = (unsigned)(Rb * K + C) * 2u; }
    const size_t kstep = (size_t)(BK * 2);
    const size_t hstep = (size_t)HALF * K * 2;
    const size_t tstep = 2 * hstep;
    const unsigned ldsw = (unsigned)wid * 1024u;
    const int aoff = lds_byte(wr * 64 + fr, fq * 8), boff = lds_byte(wc * 32 + fr, fq * 8);
#define PG8_SA(b, h) (((b) * 2 + (h)) * HTB)
#define PG8_SB(b, h) ((4 + (b) * 2 + (h)) * HTB)
#define PG8_STAGE(bufoff, gbase, voff) do { _Pragma("unroll") for (int _i = 0; _i < 2; ++_i) \
        __builtin_amdgcn_global_load_lds((const unsigned*)((const char*)(gbase) + (voff)[_i]), (PG8_LAS unsigned*)(lds + (bufoff) + ldsw + _i * 8192), 16, 0, 0); } while (0)
#define PG8_LDA(dst, b, h) do { _Pragma("unroll") for (int m = 0; m < 4; ++m) _Pragma("unroll") for (int k = 0; k < 2; ++k) dst[m][k] = *(const PG8_LAS bf16x8*)(lds + PG8_SA(b, h) + aoff + m * 2048 + k * 1024); } while (0)
#define PG8_LDB(dst, b, h) do { _Pragma("unroll") for (int n = 0; n < 2; ++n) _Pragma("unroll") for (int k = 0; k < 2; ++k) dst[n][k] = *(const PG8_LAS bf16x8*)(lds + PG8_SB(b, h) + boff + n * 2048 + k * 1024); } while (0)
#define PG8_MMA(ai, bj, At, Bt) do { __builtin_amdgcn_s_setprio(1); _Pragma("unroll") for (int m = 0; m < 4; ++m) _Pragma("unroll") for (int n = 0; n < 2; ++n) _Pragma("unroll") for (int k = 0; k < 2; ++k) \
        acc[ai][bj][m][n] = __builtin_amdgcn_mfma_f32_16x16x32_bf16(Bt[n][k], At[m][k], acc[ai][bj][m][n], 0, 0, 0); __builtin_amdgcn_s_setprio(0); } while (0)
#define PG8_WAIT_V(n) asm volatile("s_waitcnt vmcnt(" #n ")" ::: "memory")
#define PG8_WAIT_L(n) asm volatile("s_waitcnt lgkmcnt(" #n ")" ::: "memory")
#define PG8_BAR __builtin_amdgcn_s_barrier()
#define PG8_SCHED __builtin_amdgcn_sched_barrier(0)
    Unit cur, nxt; int ui = 0;
    if (!S.next(0, cur)) return;
    f32x4 acc[2][2][4][2];
#pragma unroll
    for (int a = 0; a < 2; ++a)
#pragma unroll
        for (int b = 0; b < 2; ++b)
#pragma unroll
            for (int m = 0; m < 4; ++m)
#pragma unroll
                for (int n = 0; n < 2; ++n) acc[a][b][m][n] = (f32x4){0.f, 0.f, 0.f, 0.f};
    bf16x8 At[4][2], B0[2][2], B1[2][2];
    const char* cA = (const char*)g.A + (size_t)cur.pm * tstep; const char* cB = (const char*)g.Bt + (size_t)cur.pn * tstep;
    S.a_ready(cur);
    if constexpr (SP2) {
        PG8_STAGE(PG8_SB(0, 0), cB, voffB); PG8_STAGE(PG8_SB(0, 1), cB + hstep, voffB); PG8_STAGE(PG8_SA(0, 0), cA, voffA); PG8_STAGE(PG8_SA(0, 1), cA + hstep, voffA);
        if (wr == 1) PG8_BAR;
        PG8_WAIT_V(2); PG8_BAR;
        PG8_STAGE(PG8_SB(1, 0), cB + kstep, voffB); PG8_STAGE(PG8_SA(1, 0), cA + kstep, voffA); PG8_STAGE(PG8_SB(1, 1), cB + hstep + kstep, voffB);
        PG8_WAIT_V(6); PG8_BAR;
    } else {
        PG8_STAGE(PG8_SB(0, 0), cB, voffB); PG8_STAGE(PG8_SA(0, 0), cA, voffA); PG8_STAGE(PG8_SB(0, 1), cB + hstep, voffB); PG8_STAGE(PG8_SA(0, 1), cA + hstep, voffA);
        if (wr == 1) PG8_BAR;
        PG8_WAIT_V(4); PG8_BAR;
        PG8_STAGE(PG8_SB(1, 0), cB + kstep, voffB); PG8_STAGE(PG8_SA(1, 0), cA + kstep, voffA); PG8_STAGE(PG8_SB(1, 1), cB + hstep + kstep, voffB);
        PG8_WAIT_V(6); PG8_BAR;
    }
    for (;;) {
        const bool has_next = S.next(ui + 1, nxt);
        const char* nA = has_next ? (const char*)g.A + (size_t)nxt.pm * tstep : cA; const char* nB = has_next ? (const char*)g.Bt + (size_t)nxt.pn * tstep : cB;
        for (int t = 0; t < nt; t += 2) {
            const bool last = (t == nt - 2);
            const char* a1 = cA + (size_t)(t + 1) * kstep;
            const char* a2 = last ? nA : cA + (size_t)(t + 2) * kstep; const char* b2 = last ? nB : cB + (size_t)(t + 2) * kstep;
            const char* a3 = a2 + kstep; const char* b3 = b2 + kstep;
            if (last && has_next) S.a_ready(nxt);
            if constexpr (SP2) {
            PG8_LDB(B0, 0, 0); PG8_LDB(B1, 0, 1); PG8_SCHED; PG8_LDA(At, 0, 0); PG8_STAGE(PG8_SA(1, 1), a1 + hstep, voffA);
            PG8_WAIT_V(8); PG8_WAIT_L(0); PG8_BAR; PG8_MMA(0, 0, At, B0); PG8_MMA(0, 1, At, B1); PG8_BAR; PG8_SCHED;
            PG8_LDA(At, 0, 1); PG8_STAGE(PG8_SB(0, 0), b2, voffB); PG8_STAGE(PG8_SB(0, 1), b2 + hstep, voffB); PG8_STAGE(PG8_SA(0, 0), a2, voffA);
            PG8_WAIT_V(8); PG8_WAIT_L(0); PG8_BAR; PG8_MMA(1, 0, At, B0); PG8_MMA(1, 1, At, B1); PG8_BAR; PG8_SCHED;
            PG8_LDB(B0, 1, 0); PG8_LDB(B1, 1, 1); PG8_SCHED; PG8_LDA(At, 1, 0); PG8_STAGE(PG8_SA(0, 1), a2 + hstep, voffA);
            PG8_WAIT_V(8); PG8_WAIT_L(0); PG8_BAR; PG8_MMA(0, 0, At, B0); PG8_MMA(0, 1, At, B1); PG8_BAR; PG8_SCHED;
            PG8_LDA(At, 1, 1); PG8_STAGE(PG8_SB(1, 0), b3, voffB); PG8_STAGE(PG8_SB(1, 1), b3 + hstep, voffB); PG8_STAGE(PG8_SA(1, 0), a3, voffA);
            PG8_WAIT_V(8); PG8_WAIT_L(0); PG8_BAR; PG8_MMA(1, 0, At, B0); PG8_MMA(1, 1, At, B1); PG8_BAR; PG8_SCHED;
            } else {
            PG8_LDB(B0, 0, 0); PG8_SCHED; PG8_LDA(At, 0, 0); PG8_STAGE(PG8_SA(1, 1), a1 + hstep, voffA);
            PG8_WAIT_L(8); PG8_BAR; PG8_WAIT_L(0); PG8_MMA(0, 0, At, B0); PG8_BAR; PG8_SCHED;
            PG8_LDB(B1, 0, 1); PG8_STAGE(PG8_SB(0, 0), b2, voffB);
            PG8_BAR; PG8_WAIT_L(0); PG8_MMA(0, 1, At, B1); PG8_BAR;
            PG8_LDA(At, 0, 1); PG8_STAGE(PG8_SA(0, 0), a2, voffA);
            PG8_BAR; PG8_WAIT_L(0); PG8_MMA(1, 0, At, B0); PG8_BAR; PG8_SCHED;
            PG8_STAGE(PG8_SB(0, 1), b2 + hstep, voffB);
            PG8_WAIT_V(6); PG8_BAR; PG8_MMA(1, 1, At, B1); PG8_BAR;
            PG8_LDB(B0, 1, 0); PG8_SCHED; PG8_LDA(At, 1, 0); PG8_STAGE(PG8_SA(0, 1), a2 + hstep, voffA);
            PG8_WAIT_L(8); PG8_BAR; PG8_WAIT_L(0); PG8_MMA(0, 0, At, B0); PG8_BAR; PG8_SCHED;
            PG8_LDB(B1, 1, 1); PG8_STAGE(PG8_SB(1, 0), b3, voffB);
            PG8_BAR; PG8_WAIT_L(0); PG8_MMA(0, 1, At, B1); PG8_BAR;
            PG8_LDA(At, 1, 1); PG8_STAGE(PG8_SA(1, 0), a3, voffA);
            PG8_BAR; PG8_WAIT_L(0); PG8_MMA(1, 0, At, B0); PG8_BAR; PG8_SCHED;
            PG8_STAGE(PG8_SB(1, 1), b3 + hstep, voffB);
            PG8_WAIT_V(6); PG8_BAR; PG8_MMA(1, 1, At, B1); PG8_BAR;
            }
        }
        if constexpr (ALIGN_EPI) { if (wr == 0) PG8_BAR; }
        if constexpr (!Epi::AFTER_DRAIN) { E(acc, cur, wr, wc, fr, fq); S.done(cur); }
        if (!has_next) break;
#pragma unroll
        for (int a = 0; a < 2; ++a)
#pragma unroll
            for (int b = 0; b < 2; ++b)
#pragma unroll
                for (int m = 0; m < 4; ++m)
#pragma unroll
                    for (int n = 0; n < 2; ++n) acc[a][b][m][n] = (f32x4){0.f, 0.f, 0.f, 0.f};
        cur = nxt; cA = nA; cB = nB; ++ui;
        if constexpr (ALIGN_EPI) { if (wr == 1) PG8_BAR; }
    }
    PG8_WAIT_V(0);
    if constexpr (!ALIGN_EPI) { if (wr == 0) PG8_BAR; }
    PG8_BAR;
    if constexpr (Epi::AFTER_DRAIN) { E.fused(acc, cur, wr, wc, fr, fq, lds, wid, lane); S.done(cur); }
#undef PG8_SA
#undef PG8_SB
#undef PG8_STAGE
#undef PG8_LDA
#undef PG8_LDB
#undef PG8_MMA
#undef PG8_WAIT_V
#undef PG8_WAIT_L
#undef PG8_BAR
#undef PG8_SCHED
}
}

#define DI __device__ __forceinline__
#define LAS __attribute__((address_space(3)))
typedef unsigned short bf16;
typedef short bf16x8 __attribute__((ext_vector_type(8)));
typedef float f32x4 __attribute__((ext_vector_type(4)));
typedef float f32x2 __attribute__((ext_vector_type(2)));
typedef float f32x16 __attribute__((ext_vector_type(16)));
typedef unsigned u32x4 __attribute__((ext_vector_type(4)));
typedef unsigned u32x2 __attribute__((ext_vector_type(2)));
typedef __bf16 bf16x2_t __attribute__((ext_vector_type(2)));

constexpr int DM = 1024, NPB = 16, NPL = 256, NSB = 8, NSL = 4096, PAST = 512, NLAYER = 4;
constexpr int MP = NPB * NPL;
constexpr int MS = NSB * NSL;
constexpr int MT = MP + MS;
constexpr int NINP = 1536, DFF = 2816, NF1 = 5632;
constexpr int LKS = NSL + PAST;
constexpr int KROWS = MP + NSB * LKS;
constexpr float EPS = 1e-6f;
constexpr float QSC_A = 0.125f * 1.4426950408889634f;
constexpr float QSC_B = 0.10206207261596575f * 1.4426950408889634f;
constexpr int LDS_BYTES = 147456;
constexpr int NPHASE = 3 + 9 * NLAYER;

constexpr size_t O_K = (size_t)MT * 1024, O_V = O_K + 2097152, O_CKV = O_V + 2097152, O_KR = O_CKV + 2097152, O_SRE = O_KR + 524288, O_SIM = O_SRE + 131072;

constexpr size_t WS_WIN = 0;
constexpr size_t WS_WOUT = WS_WIN + 4ull * 1536 * 1024 * 2;
constexpr size_t WS_WF1 = WS_WOUT + 4ull * 1024 * 1024 * 2;
constexpr size_t WS_WF2 = WS_WF1 + 4ull * 5632 * 1024 * 2;
constexpr size_t WS_WUQ = WS_WF2 + 4ull * 1024 * 2816 * 2;
constexpr size_t WS_WUKV = WS_WUQ + 4ull * 576 * 256 * 2;
constexpr size_t WS_WGLU = WS_WUKV + 4ull * 768 * 128 * 2;
constexpr size_t WS_MODP = WS_WGLU + 4ull * 256 * 256 * 2;
constexpr size_t WS_MOD = WS_MODP + 4ull * 8 * 9 * 6144 * 4;
constexpr size_t WS_H = WS_MOD + 4ull * 9 * 6144 * 4;
constexpr size_t WS_U0 = WS_H + (size_t)MT * 1024 * 2;
constexpr size_t WS_PROJ = WS_U0;
constexpr size_t WS_QA = WS_PROJ + (size_t)MT * 1536 * 2;
constexpr size_t WS_QB = WS_QA + (size_t)MT * 384 * 2;
constexpr size_t WS_KA = WS_QB + (size_t)MT * 576 * 2;
constexpr size_t WS_VTA = WS_KA + (size_t)KROWS * 128 * 2;
constexpr size_t WS_KB = WS_VTA + (size_t)KROWS * 128 * 2;
constexpr size_t WS_VTB = WS_KB + (size_t)KROWS * 576 * 2;
constexpr size_t WS_UU = WS_VTB + (size_t)KROWS * 384 * 2;
constexpr size_t WS_END = WS_UU + (size_t)MT * 256 * 2;
constexpr size_t WS_BAR = WS_END;
constexpr size_t WS_TOTAL = WS_END + 16384;
constexpr size_t WS_HDN = WS_U0;
static_assert(WS_HDN + (size_t)MT * 2816 * 2 <= WS_END, "hdn overlay");
static_assert(WS_TOTAL <= 536870912ull, "ws budget");

struct Args { const float* in[36]; float* out; unsigned char* ws; int ph_lo, ph_hi; };

DI unsigned pk2(float lo, float hi) { f32x2 v = {lo, hi}; bf16x2_t b = __builtin_convertvector(v, bf16x2_t); return __builtin_bit_cast(unsigned, b); }
DI unsigned short f2bf(float f) { return (unsigned short)(pk2(f, 0.f) & 0xffffu); }
DI float bf2f(unsigned short b) { return __uint_as_float(((unsigned)b) << 16); }
DI float bflo(unsigned u) { return __uint_as_float(u << 16); }
DI float bfhi(unsigned u) { return __uint_as_float(u & 0xffff0000u); }
DI float wave_sum(float v) {
#pragma unroll
    for (int o = 1; o < 64; o <<= 1) v += __shfl_xor(v, o);
    return v;
}
DI int crow(int r, int hi) { return (r & 3) + 8 * (r >> 2) + 4 * hi; }
DI int swap23(int r) { return (r & ~12) | ((r & 4) << 1) | ((r & 8) >> 1); }
DI int cond_of_row(int m) { return m < MP ? 0 : 1 + ((m - MP) >> 12); }
DI float rsq(float x) { return 1.0f / sqrtf(x); }
DI void sincos_acc(float y, float& s, float& c) {
    const float n = rintf(y * 0.6366197723675814f);
    float r = fmaf(n, -1.5707962513e+00f, y); r = fmaf(n, -7.5497894159e-08f, r); r = fmaf(n, -5.3903029534e-15f, r);
    const float r2 = r * r;
    float sp = fmaf(r2, 2.7557319e-6f, -1.9841270e-4f); sp = fmaf(sp, r2, 8.3333333e-3f); sp = fmaf(sp, r2, -1.6666667e-1f); sp = fmaf(sp * r2, r, r);
    float cp = fmaf(r2, 2.4801587e-5f, -1.3888889e-3f); cp = fmaf(cp, r2, 4.1666667e-2f); cp = fmaf(cp, r2, -0.5f); cp = fmaf(cp, r2, 1.0f);
    const int q = ((int)n) & 3;
    const float ss = (q & 1) ? cp : sp, cc = (q & 1) ? sp : cp;
    s = (q & 2) ? -ss : ss; c = ((q + 1) & 2) ? -cc : cc;
}
DI float expm1_acc(float x) {
    if (fabsf(x) < 0.35f) { float p = fmaf(x, 1.f / 40320.f, 1.f / 5040.f); p = fmaf(p, x, 1.f / 720.f); p = fmaf(p, x, 1.f / 120.f); p = fmaf(p, x, 1.f / 24.f); p = fmaf(p, x, 1.f / 6.f); p = fmaf(p, x, 0.5f); return fmaf(p * x, x, x); }
    return expf(x) - 1.f;
}
#define MFMA32(a, b, c) __builtin_amdgcn_mfma_f32_32x32x16_bf16((a), (b), (c), 0, 0, 0)
#define MFMA16(a, b, c) __builtin_amdgcn_mfma_f32_16x16x32_bf16((a), (b), (c), 0, 0, 0)
#define LDS_FENCE() asm volatile("s_waitcnt lgkmcnt(0)" ::: "memory")

struct EpiRes {
    static constexpr bool PERM = true, AFTER_DRAIN = false;
    const float* base_p; const float* base_s;
    float* out; const float* gate;
    DI void operator()(const pg8::f32x4 (&acc)[2][2][4][2], const pg8::Unit& u, int wr, int wc, int fr, int fq) const {
        const int row0 = u.pm * 256 + wr * 64 + fr; const int cnd = cond_of_row(u.pm * 256);
        const float* g = gate + cnd * 6144; const int col0 = u.pn * 256 + wc * 32 + 8 * fq;
        f32x4 gv[2][2];
#pragma unroll
        for (int bj = 0; bj < 2; ++bj)
#pragma unroll
            for (int n = 0; n < 2; ++n) gv[bj][n] = *(const f32x4*)(g + col0 + bj * 128 + n * 4);
        const float* bb = (u.pm * 256 < MP) ? base_p + (size_t)row0 * 1024 : base_s + (size_t)(row0 - MP) * 1024;
        float* oo = out + (size_t)row0 * 1024;
#pragma unroll
        for (int ai = 0; ai < 2; ++ai)
#pragma unroll
            for (int m = 0; m < 4; ++m) { const size_t ro = (size_t)(ai * 128 + m * 16) * 1024;
#pragma unroll
                for (int bj = 0; bj < 2; ++bj)
#pragma unroll
                    for (int n = 0; n < 2; ++n) { const int c = col0 + bj * 128 + n * 4; const f32x4 b = *(const f32x4*)(bb + ro + c); *(f32x4*)(oo + ro + c) = b + gv[bj][n] * acc[ai][bj][m][n]; } }
    }
};
struct EpiSwiglu {
    static constexpr bool PERM = true, AFTER_DRAIN = false;
    bf16* O;
    DI void operator()(const pg8::f32x4 (&acc)[2][2][4][2], const pg8::Unit& u, int wr, int wc, int fr, int fq) const {
        const int row0 = u.pm * 256 + wr * 64 + fr; const int hcol0 = u.pn * 128 + wc * 32 + 8 * fq;
#pragma unroll
        for (int ai = 0; ai < 2; ++ai)
#pragma unroll
            for (int m = 0; m < 4; ++m) { float v[8];
#pragma unroll
                for (int n = 0; n < 2; ++n) { const f32x4 g = acc[ai][0][m][n], up = acc[ai][1][m][n];
#pragma unroll
                    for (int e = 0; e < 4; ++e) v[4 * n + e] = g[e] * __builtin_amdgcn_rcpf(1.f + __expf(-g[e])) * up[e]; }
                u32x4 o; o.x = pk2(v[0], v[1]); o.y = pk2(v[2], v[3]); o.z = pk2(v[4], v[5]); o.w = pk2(v[6], v[7]);
                *(u32x4*)(O + (size_t)(row0 + ai * 128 + m * 16) * DFF + hcol0) = o; }
    }
};

DI int rowmap(int mode, int n) { if (mode == 0) return n; if (n < DFF) return 256 * (n >> 7) + (n & 127); n -= DFF; return 256 * (n >> 7) + 128 + (n & 127); }
DI void transpose_item(const float* W, int K, int N, bf16* WT, int row_off, int mode, LAS float* scr, int item, int lane) {
    const int nblk = N / 32, kb = item / nblk, nb = item % nblk, k0 = 64 * kb, n0 = 32 * nb;
#pragma unroll 8
    for (int i = 0; i < 32; ++i) { const int kk = 2 * i + (lane >> 5); scr[kk * 33 + (lane & 31)] = W[(size_t)(k0 + kk) * N + n0 + (lane & 31)]; }
    LDS_FENCE();
    const int c = lane & 7;
#pragma unroll
    for (int j = 0; j < 4; ++j) { const int n = (lane >> 3) + 8 * j; const LAS float* s = scr + (8 * c) * 33 + n;
        u32x4 o; o.x = pk2(s[0 * 33], s[1 * 33]); o.y = pk2(s[2 * 33], s[3 * 33]); o.z = pk2(s[4 * 33], s[5 * 33]); o.w = pk2(s[6 * 33], s[7 * 33]);
        *(u32x4*)(WT + (size_t)(row_off + rowmap(mode, n0 + n)) * K + k0 + 8 * c) = o; }
    LDS_FENCE();
}
DI void p0_convert(const Args& a, LAS unsigned char* lds, int gw, int ngw, int w, int lane) {
    LAS float* scr = (LAS float*)(lds + w * 16384);
    constexpr int I_IN = 16 * 41, I_OUT = 16 * 32, I_F1 = 16 * 176, I_F2 = 44 * 32, I_UQ = 4 * 18, I_UK = 2 * 12, I_GLU = 4 * 8;
    constexpr int PER = I_IN + I_OUT + I_F1 + I_F2 + I_UQ + 2 * I_UK + I_GLU;
    for (int it = gw; it < PER * NLAYER; it += ngw) {
        const int l = it / PER; int r = it % PER;
        if (r < I_IN) { transpose_item(a.in[14] + (size_t)l * 1024 * 1312, 1024, 1312, (bf16*)(a.ws + WS_WIN) + (size_t)l * 1536 * 1024, 0, 0, scr, r, lane); continue; } r -= I_IN;
        if (r < I_OUT) { transpose_item(a.in[32] + (size_t)l * 1024 * 1024, 1024, 1024, (bf16*)(a.ws + WS_WOUT) + (size_t)l * 1024 * 1024, 0, 0, scr, r, lane); continue; } r -= I_OUT;
        if (r < I_F1) { transpose_item(a.in[33] + (size_t)l * 1024 * 5632, 1024, 5632, (bf16*)(a.ws + WS_WF1) + (size_t)l * 5632 * 1024, 0, 1, scr, r, lane); continue; } r -= I_F1;
        if (r < I_F2) { transpose_item(a.in[34] + (size_t)l * 2816 * 1024, 2816, 1024, (bf16*)(a.ws + WS_WF2) + (size_t)l * 1024 * 2816, 0, 0, scr, r, lane); continue; } r -= I_F2;
        if (r < I_UQ) { transpose_item(a.in[19] + (size_t)l * 256 * 576, 256, 576, (bf16*)(a.ws + WS_WUQ) + (size_t)l * 576 * 256, 0, 0, scr, r, lane); continue; } r -= I_UQ;
        if (r < I_UK) { transpose_item(a.in[20] + (size_t)l * 128 * 384, 128, 384, (bf16*)(a.ws + WS_WUKV) + (size_t)l * 768 * 128, 0, 0, scr, r, lane); continue; } r -= I_UK;
        if (r < I_UK) { transpose_item(a.in[21] + (size_t)l * 128 * 384, 128, 384, (bf16*)(a.ws + WS_WUKV) + (size_t)l * 768 * 128, 384, 0, scr, r, lane); continue; } r -= I_UK;
        transpose_item(a.in[30] + (size_t)l * 256 * 256, 256, 256, (bf16*)(a.ws + WS_WGLU) + (size_t)l * 256 * 256, 0, 0, scr, r, lane);
    }
    for (int i = gw * 64 + lane; i < NLAYER * 28672; i += ngw * 64) { const int l = i / 28672, r = i % 28672;
        *(u32x4*)((bf16*)(a.ws + WS_WIN) + ((size_t)l * 1536 + 1312) * 1024 + (size_t)r * 8) = (u32x4){0u, 0u, 0u, 0u}; }
}
DI void ada_partial_item(const Args& a, LAS unsigned char* lds, int it, int tid) {
    const int l = it / 192, r = it % 192, cb = r >> 3, ks = r & 7;
    LAS float* s = (LAS float*)lds;
    LAS float* red = (LAS float*)(lds + 8192);
    const float* c_in = a.in[8]; const float* c_ctx = a.in[9];
    for (int i = tid; i < 9 * 128; i += 512) { const int c = i >> 7, k = i & 127, kk = ks * 128 + k; const float x = c == 0 ? c_ctx[kk] : c_in[(c - 1) * 1024 + kk]; s[i] = x / (1.f + expf(-x)); }
    __syncthreads();
    const int col = cb * 256 + (tid & 255), half = tid >> 8;
    const float* W = a.in[12] + ((size_t)l * 1024 + ks * 128 + half * 64) * 6144 + col;
    float acc[9];
#pragma unroll
    for (int c = 0; c < 9; ++c) acc[c] = 0.f;
#pragma unroll 4
    for (int k = 0; k < 64; ++k) { const float wv = W[(size_t)k * 6144];
#pragma unroll
        for (int c = 0; c < 9; ++c) acc[c] = fmaf(s[c * 128 + half * 64 + k], wv, acc[c]); }
    if (half == 1) {
#pragma unroll
        for (int c = 0; c < 9; ++c) red[c * 256 + (tid & 255)] = acc[c]; }
    __syncthreads();
    if (half == 0) { float* P = (float*)(a.ws + WS_MODP) + ((size_t)(l * 8 + ks) * 9) * 6144;
#pragma unroll
        for (int c = 0; c < 9; ++c) P[(size_t)c * 6144 + col] = acc[c] + red[c * 256 + tid]; }
    __syncthreads();
}

DI void norm_rows(const float* xp, const float* xs, const float* g, const float* mod_l, int sh_off, int sc_off, bf16* H, int gw, int ngw, int lane) {
    for (int m = gw; m < MT; m += ngw) {
        const float* xr = (m < MP) ? xp + (size_t)m * 1024 : xs + (size_t)(m - MP) * 1024;
        f32x4 v[4]; float ss = 0.f;
#pragma unroll
        for (int j = 0; j < 4; ++j) { v[j] = ((const f32x4*)xr)[lane + 64 * j]; ss += (v[j].x * v[j].x + v[j].y * v[j].y) + (v[j].z * v[j].z + v[j].w * v[j].w); }
        const float rstd = rsq(wave_sum(ss) * (1.f / 1024.f) + EPS);
        const float* md = mod_l + cond_of_row(m) * 6144;
        u32x2* o8 = (u32x2*)(H + (size_t)m * 1024);
#pragma unroll
        for (int j = 0; j < 4; ++j) { const int idx = 4 * (lane + 64 * j);
            const f32x4 gg = *(const f32x4*)(g + idx), sc = *(const f32x4*)(md + sc_off + idx), sh = *(const f32x4*)(md + sh_off + idx);
            const f32x4 o = v[j] * rstd * gg * (sc + 1.0f) + sh; u32x2 pk; pk.x = pk2(o.x, o.y); pk.y = pk2(o.z, o.w); o8[lane + 64 * j] = pk; }
    }
}
DI void final_norm_rows(float* X, const float* g, int gw, int ngw, int lane) {
    for (int m = gw; m < MT; m += ngw) {
        f32x4* xr = (f32x4*)(X + (size_t)m * 1024);
        f32x4 v[4]; float ss = 0.f;
#pragma unroll
        for (int j = 0; j < 4; ++j) { v[j] = xr[lane + 64 * j]; ss += (v[j].x * v[j].x + v[j].y * v[j].y) + (v[j].z * v[j].z + v[j].w * v[j].w); }
        const float rstd = rsq(wave_sum(ss) * (1.f / 1024.f) + EPS);
#pragma unroll
        for (int j = 0; j < 4; ++j) { const f32x4 gg = *(const f32x4*)(g + 4 * (lane + 64 * j)); xr[lane + 64 * j] = v[j] * rstd * gg; }
    }
}


template <int NB, int NK, int PA, int KW>
DI void small_gemm(const LAS bf16* A, const bf16* W, int krot, f32x4 (&acc)[NB][2], int n16, int kq) {
    bf16x8 bb[2][NB];
    { const int ks = krot & (NK - 1);
#pragma unroll
      for (int c = 0; c < NB; ++c) bb[0][c] = *(const bf16x8*)(W + (size_t)c * 16 * KW + ks * 32); }
#pragma unroll
    for (int i = 0; i < NK; ++i) { const int cur = i & 1, ks = (i + krot) & (NK - 1);
        if (i + 1 < NK) { const int kn = (i + 1 + krot) & (NK - 1);
#pragma unroll
            for (int c = 0; c < NB; ++c) bb[cur ^ 1][c] = *(const bf16x8*)(W + (size_t)c * 16 * KW + kn * 32); }
        const bf16x8 a0 = *(const LAS bf16x8*)(A + n16 * PA + ks * 32 + 8 * kq), a1 = *(const LAS bf16x8*)(A + (16 + n16) * PA + ks * 32 + 8 * kq);
        __builtin_amdgcn_sched_barrier(0);
#pragma unroll
        for (int c = 0; c < NB; ++c) { acc[c][0] = MFMA16(a0, bb[cur][c], acc[c][0]); acc[c][1] = MFMA16(a1, bb[cur][c], acc[c][1]); }
        __builtin_amdgcn_sched_barrier(0);
    }
}

constexpr int L2_TAB = 0;
constexpr int L2_ACQ = 12288;
constexpr int L2_ACKV = L2_ACQ + 16896;
constexpr int L2_QBS = L2_ACKV + 8704;
constexpr int L2_KBS = L2_QBS + 36864;
constexpr int L2_VTBS = L2_KBS + 36864;
constexpr int L2_VTAS = L2_VTBS + 24576;
static_assert(L2_VTAS + 8192 <= LDS_BYTES, "L2 LDS");
DI size_t vtbase(int seq, int C) { return seq < 16 ? (size_t)seq * C * 256 : (size_t)16 * C * 256 + (size_t)(seq - 16) * C * LKS; }

DI void post_tables(LAS unsigned char* lds, int tid) {
    LAS float* c16 = (LAS float*)(lds + L2_TAB); LAS float* s16 = c16 + 1024; LAS float* c8 = c16 + 2048; LAS float* s8 = c16 + 2560;
    for (int i = tid; i < 1024; i += 512) { const int p = i >> 4, f = i & 15; const float inv = exp2f(-(float)f * (13.287712379549449f / 16.f)); float s, c; sincos_acc((float)p * inv, s, c); c16[i] = c; s16[i] = s; }
    for (int i = tid; i < 512; i += 512) { const int p = i >> 3, f = i & 7; const float inv = exp2f(-(float)f * (13.287712379549449f / 8.f)); float s, c; sincos_acc((float)p * inv, s, c); c8[i] = c; s8[i] = s; }
}

template <int PABL>
DI void post_item(const Args& a, LAS unsigned char* lds, int l, int item, int tid, int lane, int w) {
    const bool is_cache = item >= 1152;
    int m0 = 0, seq, t0, krow0; bool sample;
    if (!is_cache) { m0 = item * 32;
        if (m0 < MP) { seq = m0 >> 8; t0 = m0 & 255; sample = false; krow0 = m0; }
        else { const int r = m0 - MP; seq = 16 + (r >> 12); t0 = r & 4095; sample = true; krow0 = MP + (seq - 16) * LKS + t0; } }
    else { const int j = item - 1152, b = j >> 4; seq = 16 + b; t0 = NSL + (j & 15) * 32; sample = true; krow0 = MP + b * LKS + t0; }
    const int Lk = seq < 16 ? 256 : LKS;
    const LAS float* c16 = (const LAS float*)(lds + L2_TAB); const LAS float* s16 = c16 + 1024; const LAS float* c8 = c16 + 2048; const LAS float* s8 = c16 + 2560;
    LAS bf16* ACQ = (LAS bf16*)(lds + L2_ACQ); LAS bf16* ACKV = (LAS bf16*)(lds + L2_ACKV);
    LAS bf16* QBS = (LAS bf16*)(lds + L2_QBS); LAS bf16* KBS = (LAS bf16*)(lds + L2_KBS);
    LAS bf16* VTBS = (LAS bf16*)(lds + L2_VTBS); LAS bf16* VTAS = (LAS bf16*)(lds + L2_VTAS);
    bf16* QA = (bf16*)(a.ws + WS_QA); bf16* QB = (bf16*)(a.ws + WS_QB); bf16* KA = (bf16*)(a.ws + WS_KA); bf16* KB = (bf16*)(a.ws + WS_KB);
    bf16* VTA = (bf16*)(a.ws + WS_VTA); bf16* VTB = (bf16*)(a.ws + WS_VTB); bf16* UU = (bf16*)(a.ws + WS_UU);
    const bf16* PROJ = (const bf16*)(a.ws + WS_PROJ);
    if (PABL & 1) {} else
    if (!is_cache) {
        const int hd = lane >> 3, sub = lane & 7;
        const float* nw = (hd < 6) ? a.in[15] + l * 64 : a.in[16] + l * 64;
        const f32x4 nw0 = *(const f32x4*)(nw + 4 * sub), nw1 = *(const f32x4*)(nw + 32 + 4 * sub);
        const int e2 = (lane < 16) ? 512 + 8 * lane : (lane < 48) ? 640 + 8 * (lane - 16) : 896 + 8 * (lane - 48);
        const float* n2p = (lane < 48) ? a.in[17] + l * 256 + 8 * ((lane - 16) & 31) : a.in[18] + l * 128 + 8 * (lane - 48);
        const f32x4 n20 = *(const f32x4*)n2p, n21 = *(const f32x4*)(n2p + 4);
        u32x2 qa0[4], qa1[4]; u32x4 ld2[4]; u32x2 kr0[4], kr1[4]; u32x4 ldu[4];
#pragma unroll
        for (int rr = 0; rr < 4; ++rr) { const bf16* pr = PROJ + (size_t)(m0 + 4 * w + rr) * NINP;
            qa0[rr] = *(const u32x2*)(pr + hd * 64 + 4 * sub); qa1[rr] = *(const u32x2*)(pr + hd * 64 + 32 + 4 * sub);
            ld2[rr] = *(const u32x4*)(pr + e2);
            if (lane < 4) { kr0[rr] = *(const u32x2*)(pr + 1024 + 4 * lane); kr1[rr] = *(const u32x2*)(pr + 1040 + 4 * lane); }
            else if (lane < 36) ldu[rr] = *(const u32x4*)(pr + 1056 + 8 * (lane - 4)); }
#pragma unroll
        for (int rr = 0; rr < 4; ++rr) {
            const int r = 4 * w + rr, m = m0 + r, t = t0 + r, trow = t >> 6, tcol = t & 63;
            const size_t orow = (size_t)((seq * 4 + l) * 256 + t);
            { float x0[4] = {bflo(qa0[rr].x), bfhi(qa0[rr].x), bflo(qa0[rr].y), bfhi(qa0[rr].y)}, x1[4] = {bflo(qa1[rr].x), bfhi(qa1[rr].x), bflo(qa1[rr].y), bfhi(qa1[rr].y)};
              float ss = (x0[0] * x0[0] + x0[1] * x0[1]) + (x0[2] * x0[2] + x0[3] * x0[3]) + (x1[0] * x1[0] + x1[1] * x1[1]) + (x1[2] * x1[2] + x1[3] * x1[3]);
              ss += __shfl_xor(ss, 1); ss += __shfl_xor(ss, 2); ss += __shfl_xor(ss, 4);
              const float rs = rsq(ss * (1.f / 64.f) + EPS);
#pragma unroll
              for (int e = 0; e < 4; ++e) { x0[e] *= rs * nw0[e]; x1[e] *= rs * nw1[e]; }
              if (hd >= 6 && !sample) { float* ok = a.out + O_K + (orow * 2 + (hd - 6)) * 64; *(f32x4*)(ok + 4 * sub) = (f32x4){x0[0], x0[1], x0[2], x0[3]}; *(f32x4*)(ok + 32 + 4 * sub) = (f32x4){x1[0], x1[1], x1[2], x1[3]}; }
              if (sample) { const int p16 = (sub < 4) ? trow : tcol; const f32x4 cs = *(const LAS f32x4*)(c16 + p16 * 16 + 4 * (sub & 3)), sn = *(const LAS f32x4*)(s16 + p16 * 16 + 4 * (sub & 3));
#pragma unroll
                  for (int e = 0; e < 4; ++e) { const float a1 = x0[e], a2 = x1[e]; x0[e] = a1 * cs[e] - a2 * sn[e]; x1[e] = a1 * sn[e] + a2 * cs[e]; } }
              const float sc = (hd < 6) ? QSC_A : 1.f;
              u32x2 o0, o1; o0.x = pk2(x0[0] * sc, x0[1] * sc); o0.y = pk2(x0[2] * sc, x0[3] * sc); o1.x = pk2(x1[0] * sc, x1[1] * sc); o1.y = pk2(x1[2] * sc, x1[3] * sc);
              bf16* dst = (hd < 6) ? QA + (size_t)m * 384 + hd * 64 : KA + (size_t)(krow0 + r) * 128 + (hd - 6) * 64;
              *(u32x2*)(dst + 4 * sub) = o0; *(u32x2*)(dst + 32 + 4 * sub) = o1; }
            { float x[8] = {bflo(ld2[rr].x), bfhi(ld2[rr].x), bflo(ld2[rr].y), bfhi(ld2[rr].y), bflo(ld2[rr].z), bfhi(ld2[rr].z), bflo(ld2[rr].w), bfhi(ld2[rr].w)};
              float ss = (x[0] * x[0] + x[1] * x[1]) + (x[2] * x[2] + x[3] * x[3]) + (x[4] * x[4] + x[5] * x[5]) + (x[6] * x[6] + x[7] * x[7]);
              ss += __shfl_xor(ss, 1); ss += __shfl_xor(ss, 2); ss += __shfl_xor(ss, 4); ss += __shfl_xor(ss, 8);
              const float scq = __int_as_float(__builtin_amdgcn_readlane(__float_as_int(ss), 16)) + __int_as_float(__builtin_amdgcn_readlane(__float_as_int(ss), 32));
              const float skv = __int_as_float(__builtin_amdgcn_readlane(__float_as_int(ss), 48));
              if (lane < 16) {
                  if (!sample) { float* ov = a.out + O_V + orow * 128 + 8 * lane; *(f32x4*)ov = (f32x4){x[0], x[1], x[2], x[3]}; *(f32x4*)(ov + 4) = (f32x4){x[4], x[5], x[6], x[7]}; }
#pragma unroll
                  for (int e = 0; e < 8; ++e) VTAS[(8 * lane + e) * 32 + swap23(r)] = f2bf(x[e]);
              } else if (lane < 48) {
                  const float rs = rsq(scq * (1.f / 256.f) + EPS);
                  u32x4 o; o.x = pk2(x[0] * rs * n20.x, x[1] * rs * n20.y); o.y = pk2(x[2] * rs * n20.z, x[3] * rs * n20.w); o.z = pk2(x[4] * rs * n21.x, x[5] * rs * n21.y); o.w = pk2(x[6] * rs * n21.z, x[7] * rs * n21.w);
                  *(LAS u32x4*)(ACQ + r * 264 + 8 * (lane - 16)) = o;
              } else {
                  const float rs = rsq(skv * (1.f / 128.f) + EPS);
                  const float y0 = x[0] * rs * n20.x, y1 = x[1] * rs * n20.y, y2 = x[2] * rs * n20.z, y3 = x[3] * rs * n20.w, y4 = x[4] * rs * n21.x, y5 = x[5] * rs * n21.y, y6 = x[6] * rs * n21.z, y7 = x[7] * rs * n21.w;
                  if (!sample) { float* oc = a.out + O_CKV + orow * 128 + 8 * (lane - 48); *(f32x4*)oc = (f32x4){y0, y1, y2, y3}; *(f32x4*)(oc + 4) = (f32x4){y4, y5, y6, y7}; }
                  u32x4 o; o.x = pk2(y0, y1); o.y = pk2(y2, y3); o.z = pk2(y4, y5); o.w = pk2(y6, y7);
                  *(LAS u32x4*)(ACKV + r * 136 + 8 * (lane - 48)) = o;
              } }
            if (lane < 4) {
                float x0[4] = {bflo(kr0[rr].x), bfhi(kr0[rr].x), bflo(kr0[rr].y), bfhi(kr0[rr].y)}, x1[4] = {bflo(kr1[rr].x), bfhi(kr1[rr].x), bflo(kr1[rr].y), bfhi(kr1[rr].y)};
                if (!sample) { float* ok = a.out + O_KR + orow * 32; *(f32x4*)(ok + 4 * lane) = (f32x4){x0[0], x0[1], x0[2], x0[3]}; *(f32x4*)(ok + 16 + 4 * lane) = (f32x4){x1[0], x1[1], x1[2], x1[3]}; }
                else { const int p8 = (lane < 2) ? trow : tcol; const f32x4 cs = *(const LAS f32x4*)(c8 + p8 * 8 + 4 * (lane & 1)), sn = *(const LAS f32x4*)(s8 + p8 * 8 + 4 * (lane & 1));
#pragma unroll
                    for (int e = 0; e < 4; ++e) { const float a1 = x0[e], a2 = x1[e]; x0[e] = a1 * cs[e] - a2 * sn[e]; x1[e] = a1 * sn[e] + a2 * cs[e]; } }
                u32x2 o0, o1; o0.x = pk2(x0[0], x0[1]); o0.y = pk2(x0[2], x0[3]); o1.x = pk2(x1[0], x1[1]); o1.y = pk2(x1[2], x1[3]);
#pragma unroll
                for (int h = 0; h < 6; ++h) { *(LAS u32x2*)(KBS + r * 576 + h * 96 + 64 + 4 * lane) = o0; *(LAS u32x2*)(KBS + r * 576 + h * 96 + 80 + 4 * lane) = o1; }
            } else if (lane < 36) *(u32x4*)(UU + (size_t)m * 256 + 8 * (lane - 4)) = ldu[rr];
        }
    } else {
        const int b = seq - 16;
#pragma unroll 1
        for (int rr = 0; rr < 4; ++rr) {
            const int r = 4 * w + rr, p = (t0 - NSL) + r;
            const size_t cb = (size_t)(b * 4 + l) * 512 + p;
            const float* ck = a.in[2] + cb * 128; const float* cv = a.in[3] + cb * 128; const float* cc = a.in[4] + cb * 128; const float* ckr = a.in[5] + cb * 32;
            KA[(size_t)(krow0 + r) * 128 + lane] = f2bf(ck[lane]); KA[(size_t)(krow0 + r) * 128 + 64 + lane] = f2bf(ck[64 + lane]);
            VTAS[lane * 32 + swap23(r)] = f2bf(cv[lane]); VTAS[(64 + lane) * 32 + swap23(r)] = f2bf(cv[64 + lane]);
            { const f32x2 v = *(const f32x2*)(cc + lane * 2); *(LAS unsigned*)(ACKV + r * 136 + lane * 2) = pk2(v.x, v.y); }
            if (lane < 32) { const unsigned short bb = f2bf(ckr[lane]);
#pragma unroll
                for (int h = 0; h < 6; ++h) KBS[r * 576 + h * 96 + 64 + lane] = bb; }
        }
    }
    __syncthreads();
    const int n16 = lane & 15, kq = lane >> 4;
    if (!(PABL & 2)) {
    if (!is_cache && w < 6) {
        const bf16* W = (const bf16*)(a.ws + WS_WUQ) + (size_t)l * 576 * 256 + (size_t)(w * 96 + n16) * 256 + 8 * kq;
        f32x4 acc[6][2];
#pragma unroll
        for (int c = 0; c < 6; ++c) { acc[c][0] = (f32x4){0.f, 0.f, 0.f, 0.f}; acc[c][1] = (f32x4){0.f, 0.f, 0.f, 0.f}; }
        small_gemm<6, 8, 264, 256>(ACQ, W, item * 3 + w, acc, n16, kq);
#pragma unroll
        for (int rb = 0; rb < 2; ++rb)
#pragma unroll
            for (int i = 0; i < 4; ++i) { const int row = 16 * rb + 4 * kq + i;
                if (sample) { const int t = t0 + row, p8 = (n16 < 8) ? (t >> 6) : (t & 63); const float c = c8[p8 * 8 + (n16 & 7)], s = s8[p8 * 8 + (n16 & 7)];
                    const float x1 = acc[4][rb][i], x2 = acc[5][rb][i]; acc[4][rb][i] = x1 * c - x2 * s; acc[5][rb][i] = x1 * s + x2 * c; }
#pragma unroll
                for (int c = 0; c < 6; ++c) QBS[row * 576 + w * 96 + c * 16 + n16] = f2bf(acc[c][rb][i] * QSC_B); }
    }
    {
        const bf16* W = (const bf16*)(a.ws + WS_WUKV) + (size_t)l * 768 * 128 + (size_t)(w * 96 + n16) * 128 + 8 * kq;
        f32x4 acc[6][2];
#pragma unroll
        for (int c = 0; c < 6; ++c) { acc[c][0] = (f32x4){0.f, 0.f, 0.f, 0.f}; acc[c][1] = (f32x4){0.f, 0.f, 0.f, 0.f}; }
        small_gemm<6, 4, 136, 128>(ACKV, W, item * 3 + w, acc, n16, kq);
#pragma unroll
        for (int c = 0; c < 6; ++c) { const int cb = w * 6 + c;
#pragma unroll
            for (int rb = 0; rb < 2; ++rb)
#pragma unroll
                for (int i = 0; i < 4; ++i) { const int row = 16 * rb + 4 * kq + i; const unsigned short v = f2bf(acc[c][rb][i]);
                    if (w < 4) KBS[row * 576 + (cb >> 2) * 96 + (cb & 3) * 16 + n16] = v;
                    else { const int cb2 = cb - 24; VTBS[((cb2 >> 2) * 64 + (cb2 & 3) * 16 + n16) * 32 + swap23(row)] = v; } } }
    }
    }
    __syncthreads();
    if (!(PABL & 4)) {
    if (!is_cache) for (int i = tid; i < 2304; i += 512) *(u32x4*)(QB + (size_t)m0 * 576 + (size_t)i * 8) = *(const LAS u32x4*)(QBS + i * 8);
    for (int i = tid; i < 2304; i += 512) *(u32x4*)(KB + (size_t)krow0 * 576 + (size_t)i * 8) = *(const LAS u32x4*)(KBS + i * 8);
    { bf16* dst = VTB + vtbase(seq, 384) + t0;
      for (int i = tid; i < 1536; i += 512) { const int d = i >> 2, ch = i & 3; *(u32x4*)(dst + (size_t)d * Lk + ch * 8) = *(const LAS u32x4*)(VTBS + d * 32 + ch * 8); } }
    { bf16* dst = VTA + vtbase(seq, 128) + t0; const int d = tid >> 2, ch = tid & 3; *(u32x4*)(dst + (size_t)d * Lk + ch * 8) = *(const LAS u32x4*)(VTAS + d * 32 + ch * 8); }
    }
    __syncthreads();
}

DI float max3f(float a, float b, float c) { float r; asm("v_max3_f32 %0, %1, %2, %3" : "=v"(r) : "v"(a), "v"(b), "v"(c)); return r; }
#define SBAR() __builtin_amdgcn_sched_barrier(0)
template <int DQK, bool HN, int ABL>
DI void att_step(f32x16& C0, f32x16& C1, f32x16& N0, f32x16& N1, f32x16& o0, f32x16& o1, f32x16& negm, float& mref, float& lsum,
                 const bf16x8 (&qf)[DQK / 16], const LAS unsigned char* kb, const LAS unsigned char* vb) {
    constexpr int ND = DQK / 16, NQ = 2 * ND, KP = DQK * 2 + 16, VP = 144, NI = NQ > 8 ? NQ : 8;
    constexpr int AH = 4;
    bf16x8 kf[NQ];
    if (HN) {
#pragma unroll
        for (int i = 0; i < AH; ++i) kf[i] = *(const LAS bf16x8*)(kb + (i & 1) * 32 * KP + (i >> 1) * 32);
    }
    SBAR();
    u32x4 pw[4];
#pragma unroll
    for (int i = 0; i < NI; ++i) {
        if (HN && i < NQ) { if (i & 1) N1 = MFMA32(kf[i], qf[i >> 1], (i < 2) ? negm : N1); else N0 = MFMA32(kf[i], qf[i >> 1], (i < 2) ? negm : N0); }
        if (HN && i + AH < NQ) kf[i + AH] = *(const LAS bf16x8*)(kb + ((i + AH) & 1) * 32 * KP + ((i + AH) >> 1) * 32);
        if (i < 8) {
#pragma unroll
            for (int e = 0; e < 4; ++e) { const int idx = 4 * (i & 3) + e; if (ABL & 1) { if (i < 4) C0[idx] = fmaf(C0[idx], 0.001f, 1.f); else C1[idx] = fmaf(C1[idx], 0.001f, 1.f); } else { if (i < 4) C0[idx] = __builtin_amdgcn_exp2f(C0[idx]); else C1[idx] = __builtin_amdgcn_exp2f(C1[idx]); } }
            if (i & 1) { const int k = i >> 1, b8 = 8 * (k & 1);
                if (k < 2) { pw[k].x = pk2(C0[b8], C0[b8 + 1]); pw[k].y = pk2(C0[b8 + 2], C0[b8 + 3]); pw[k].z = pk2(C0[b8 + 4], C0[b8 + 5]); pw[k].w = pk2(C0[b8 + 6], C0[b8 + 7]); }
                else { pw[k].x = pk2(C1[b8], C1[b8 + 1]); pw[k].y = pk2(C1[b8 + 2], C1[b8 + 3]); pw[k].z = pk2(C1[b8 + 4], C1[b8 + 5]); pw[k].w = pk2(C1[b8 + 6], C1[b8 + 7]); } }
        }
        SBAR();
    }
    bf16x8 vf[8];
#pragma unroll
    for (int i = 0; i < AH; ++i) vf[i] = *(const LAS bf16x8*)(vb + (i & 1) * 32 * VP + (i >> 1) * 32);
    SBAR();
    float ps = 0.f, mx = -3.0e38f;
#pragma unroll
    for (int i = 0; i < 8; ++i) {
        if (i & 1) o1 = MFMA32(vf[i], __builtin_bit_cast(bf16x8, pw[i >> 1]), o1); else o0 = MFMA32(vf[i], __builtin_bit_cast(bf16x8, pw[i >> 1]), o0);
        if (i + AH < 8) vf[i + AH] = *(const LAS bf16x8*)(vb + ((i + AH) & 1) * 32 * VP + ((i + AH) >> 1) * 32);
        if (HN && i == 0) asm volatile("s_nop 11" : "+v"(N0), "+v"(N1));
#pragma unroll
        for (int e = 0; e < 4; ++e) { const int idx = 4 * (i & 3) + e; ps += (i < 4) ? C0[idx] : C1[idx]; }
        if (HN && !(ABL & 8)) { mx = max3f(mx, N0[2 * i], N1[2 * i]); mx = max3f(mx, N0[2 * i + 1], N1[2 * i + 1]); }
        SBAR();
    }
    lsum += ps;
    if (HN && !(ABL & 8)) {
        { auto rr = __builtin_amdgcn_permlane32_swap(__float_as_uint(mx), __float_as_uint(mx), false, false); mx = fmaxf(__uint_as_float(rr[0]), __uint_as_float(rr[1])); }
        if (__any(mx > 8.f)) { const float dl = fmaxf(mx, 0.f); mref += dl; const float f = __builtin_amdgcn_exp2f(-dl);
#pragma unroll
            for (int i = 0; i < 16; ++i) { N0[i] -= dl; N1[i] -= dl; negm[i] = -mref; o0[i] *= f; o1[i] *= f; }
            lsum *= f; }
    }
}

template <int DQK, int ABL>
DI void attn_unit(LAS unsigned char* lds, const bf16* Q, int qpitch, const bf16* K, int kpitch, const bf16* VT, int Lk, bf16* O, int tid_in) {
    constexpr int ND = DQK / 16, NQ = 2 * ND, KP = DQK * 2 + 16, VP = 144, NCH = DQK / 8, KBUF = 64 * KP, VBUF = 64 * VP;
    LAS unsigned char* Kl = lds; LAS unsigned char* Vl = lds + 2 * KBUF;
    int tid = tid_in; asm volatile("" : "+v"(tid));
    const int lane = tid & 63, w = __builtin_amdgcn_readfirstlane(tid >> 6);
    const int r = lane & 31, hh = lane >> 5;
    const int kr0 = tid / NCH, kc0 = tid % NCH, kr1 = (tid + 512) / NCH, kc1 = (tid + 512) % NCH;
    const bool k2 = (DQK == 96) && (tid < 256);
    const int vd = tid >> 3, vc = tid & 7;
    u32x4 kreg0, kreg1 = (u32x4){0u, 0u, 0u, 0u}, vreg;
#define ATT_LOADK(tile) do { if (ABL & 2) break; kreg0 = *(const u32x4*)(K + (size_t)((tile) * 64 + kr0) * kpitch + kc0 * 8); \
        if (k2) kreg1 = *(const u32x4*)(K + (size_t)((tile) * 64 + kr1) * kpitch + kc1 * 8); } while (0)
#define ATT_LOADV(tile) do { if (ABL & 2) break; vreg = *(const u32x4*)(VT + (size_t)vd * Lk + (tile) * 64 + vc * 8); } while (0)
#define ATT_STOREK(buf) do { if (ABL & 2) break; *(LAS u32x4*)(Kl + (buf) * KBUF + kr0 * KP + kc0 * 16) = kreg0; \
        if (k2) *(LAS u32x4*)(Kl + (buf) * KBUF + kr1 * KP + kc1 * 16) = kreg1; } while (0)
#define ATT_STOREV(buf) do { if (ABL & 2) break; *(LAS u32x4*)(Vl + (buf) * VBUF + vd * VP + vc * 16) = vreg; } while (0)
    bf16x8 qf[ND];
#pragma unroll
    for (int d0 = 0; d0 < ND; ++d0) qf[d0] = *(const bf16x8*)(Q + (size_t)(w * 32 + r) * qpitch + d0 * 16 + hh * 8);
    const int NT = Lk >> 6;
    ATT_LOADK(0); ATT_STOREK(0); ATT_LOADV(0); ATT_STOREV(0); ATT_LOADK(1); ATT_STOREK(1);
    __syncthreads();
    const LAS unsigned char* kbase = Kl + r * KP + hh * 16;
    const LAS unsigned char* vbase = Vl + r * VP + hh * 16;
    f32x16 A0, A1, B0, B1, o0, o1, negm;
#pragma unroll
    for (int i = 0; i < 16; ++i) { A0[i] = 0.f; A1[i] = 0.f; B0[i] = 0.f; B1[i] = 0.f; o0[i] = 0.f; o1[i] = 0.f; }
    {
        bf16x8 kf[NQ];
#pragma unroll
        for (int i = 0; i < NQ; ++i) kf[i] = *(const LAS bf16x8*)(kbase + (i & 1) * 32 * KP + (i >> 1) * 32);
#pragma unroll
        for (int i = 0; i < NQ; ++i) { if (i & 1) A1 = MFMA32(kf[i], qf[i >> 1], A1); else A0 = MFMA32(kf[i], qf[i >> 1], A0); }
    }
    float mref = fmaxf(A0[0], A1[0]);
#pragma unroll
    for (int i = 1; i < 16; ++i) mref = fmaxf(mref, fmaxf(A0[i], A1[i]));
    mref = fmaxf(mref, __shfl_xor(mref, 32));
#pragma unroll
    for (int i = 0; i < 16; ++i) { A0[i] -= mref; A1[i] -= mref; negm[i] = -mref; }
    float lsum = 0.f;
#pragma unroll 1
    for (int t = 0; t + 2 < NT; t += 2) {
        ATT_LOADK(t + 2); ATT_LOADV(t + 1);
        att_step<DQK, true, ABL>(A0, A1, B0, B1, o0, o1, negm, mref, lsum, qf, kbase + KBUF, vbase);
        ATT_STOREK(0); ATT_STOREV(1); if (!(ABL & 4)) __syncthreads();
        ATT_LOADK(t + 3); ATT_LOADV(t + 2);
        att_step<DQK, true, ABL>(B0, B1, A0, A1, o0, o1, negm, mref, lsum, qf, kbase, vbase + VBUF);
        ATT_STOREK(1); ATT_STOREV(0); if (!(ABL & 4)) __syncthreads();
    }
    ATT_LOADV(NT - 1);
    att_step<DQK, true, ABL>(A0, A1, B0, B1, o0, o1, negm, mref, lsum, qf, kbase + KBUF, vbase);
    ATT_STOREV(1); __syncthreads();
    att_step<DQK, false, ABL>(B0, B1, A0, A1, o0, o1, negm, mref, lsum, qf, kbase, vbase + VBUF);
    __syncthreads();
#undef ATT_LOADK
#undef ATT_LOADV
#undef ATT_STOREK
#undef ATT_STOREV
    lsum += __shfl_xor(lsum, 32);
    const float inv = 1.f / lsum;
    bf16* op = O + (size_t)(w * 32 + r) * 1024;
    if (!(ABL & 16) || lsum == 1.2345e-30f)
#pragma unroll
    for (int g4 = 0; g4 < 4; ++g4) { const int d = 8 * g4 + 4 * hh; u32x2 x0, x1;
        x0.x = pk2(o0[4 * g4] * inv, o0[4 * g4 + 1] * inv); x0.y = pk2(o0[4 * g4 + 2] * inv, o0[4 * g4 + 3] * inv);
        x1.x = pk2(o1[4 * g4] * inv, o1[4 * g4 + 1] * inv); x1.y = pk2(o1[4 * g4 + 2] * inv, o1[4 * g4 + 3] * inv);
        *(u32x2*)(op + d) = x0; *(u32x2*)(op + 32 + d) = x1; }
}

template <bool WY>
DI void s5_run(LAS float* wl, const bf16* U, float* Y, int L, int dir, int c_lo, int c_hi, const bf16x8 (&bfr)[4], const bf16x8 (&cfr)[4], float ar, float ai, float& sre, float& sim, int lane) {
    const int pl = lane & 31, hh = lane >> 5, n16 = lane & 15, kq = lane >> 4;
    f32x16 zero16;
#pragma unroll
    for (int i = 0; i < 16; ++i) zero16[i] = 0.f;
    bf16x8 uf_n0, uf_n1;
    { const int t0 = dir ? (L - 1 - c_lo - pl) : (c_lo + pl); uf_n0 = *(const bf16x8*)(U + (size_t)t0 * 256 + 8 * hh);
      const int t1 = dir ? (L - 1 - c_lo - 32 - pl) : (c_lo + 32 + pl); uf_n1 = *(const bf16x8*)(U + (size_t)t1 * 256 + 8 * hh); }
#pragma unroll 1
    for (int c0 = c_lo; c0 < c_hi; c0 += 32) {
        const bf16x8 uf = uf_n0; uf_n0 = uf_n1;
        if (c0 + 64 < c_hi) { const int t2 = dir ? (L - 1 - c0 - 64 - pl) : (c0 + 64 + pl); uf_n1 = *(const bf16x8*)(U + (size_t)t2 * 256 + 8 * hh); }
#pragma unroll
        for (int blk = 0; blk < 4; ++blk) { const f32x16 d = MFMA32(uf, bfr[blk], zero16);
#pragma unroll
            for (int i = 0; i < 16; ++i) wl[crow(i, hh) * 132 + blk * 32 + pl] = d[i]; }
        LDS_FENCE();
        {
            float br_[32], bi_[32];
#pragma unroll
            for (int tau = 0; tau < 32; ++tau) { br_[tau] = wl[tau * 132 + lane]; bi_[tau] = wl[tau * 132 + 64 + lane]; }
#pragma unroll
            for (int tau = 0; tau < 32; ++tau) { const float n_r = fmaf(ar, sre, fmaf(-ai, sim, br_[tau])), n_i = fmaf(ar, sim, fmaf(ai, sre, bi_[tau])); sre = n_r; sim = n_i; br_[tau] = n_r; bi_[tau] = n_i; }
            if (WY) {
#pragma unroll
                for (int tau = 0; tau < 32; ++tau) { wl[tau * 132 + lane] = br_[tau]; wl[tau * 132 + 64 + lane] = bi_[tau]; } }
        }
        LDS_FENCE();
        if (WY) {
#pragma unroll
            for (int rb = 0; rb < 2; ++rb) { f32x4 acc = (f32x4){0.f, 0.f, 0.f, 0.f};
#pragma unroll
                for (int ks = 0; ks < 4; ++ks) { const LAS float* sp = wl + (rb * 16 + n16) * 132 + 32 * ks + 8 * kq; const f32x4 s0 = *(const LAS f32x4*)sp, s1 = *(const LAS f32x4*)(sp + 4);
                    u32x4 pw; pw.x = pk2(s0.x, s0.y); pw.y = pk2(s0.z, s0.w); pw.z = pk2(s1.x, s1.y); pw.w = pk2(s1.z, s1.w);
                    acc = MFMA16(__builtin_bit_cast(bf16x8, pw), cfr[ks], acc); }
#pragma unroll
                for (int i = 0; i < 4; ++i) { const int tau = rb * 16 + 4 * kq + i; const int tt = dir ? (L - 1 - c0 - tau) : (c0 + tau); Y[(size_t)tt * 256 + n16] = acc[i]; } }
            LDS_FENCE();
        }
    }
}
template <bool SPLIT>
DI void s5_task(const Args& a, LAS float* wl, LAS float* xl, int l, int seq, int g, int dir, int lane, int w) {
    const int L = seq < 16 ? 256 : 4096; const int mbase = seq < 16 ? seq * 256 : MP + (seq - 16) * 4096;
    const int pidx = (l * 2 + dir) * 16 + g;
    const float lre = a.in[22][pidx * 64 + lane], lim = a.in[23][pidx * 64 + lane], dt = expf(a.in[24][pidx]);
    const float x = lre * dt, y = lim * dt, ex = expf(x); float sy, cy; sincos_acc(y, sy, cy);
    const float ar = ex * cy, ai = ex * sy;
    float shh, chh; sincos_acc(0.5f * y, shh, chh);
    const float nr = expm1_acc(x) * cy - 2.f * shh * shh, ni = ex * sy, den = lre * lre + lim * lim;
    const float cre = (nr * lre + ni * lim) / den, cim = (ni * lre - nr * lim) / den;
    const int pl = lane & 31, hh = lane >> 5, n16 = lane & 15, kq = lane >> 4;
    bf16x8 bfr[4];
#pragma unroll
    for (int blk = 0; blk < 4; ++blk) { const int ps = (blk & 1) * 32 + pl; const float cr = __shfl(cre, ps), ci = __shfl(cim, ps);
        const float* br = a.in[25] + ((size_t)pidx * 64 + ps) * 16 + 8 * hh; const float* bi = a.in[26] + ((size_t)pidx * 64 + ps) * 16 + 8 * hh;
        const f32x4 r0 = *(const f32x4*)br, r1 = *(const f32x4*)(br + 4), i0 = *(const f32x4*)bi, i1 = *(const f32x4*)(bi + 4);
        f32x4 v0, v1; if (blk < 2) { v0 = r0 * cr - i0 * ci; v1 = r1 * cr - i1 * ci; } else { v0 = i0 * cr + r0 * ci; v1 = i1 * cr + r1 * ci; }
        u32x4 pw; pw.x = pk2(v0.x, v0.y); pw.y = pk2(v0.z, v0.w); pw.z = pk2(v1.x, v1.y); pw.w = pk2(v1.z, v1.w); bfr[blk] = __builtin_bit_cast(bf16x8, pw); }
    bf16x8 cfr[4];
#pragma unroll
    for (int ks = 0; ks < 4; ++ks) { const int k0 = 32 * ks + 8 * kq; const float* src = (k0 < 64) ? a.in[27] + ((size_t)pidx * 16 + n16) * 64 + k0 : a.in[28] + ((size_t)pidx * 16 + n16) * 64 + (k0 - 64);
        const float sg = (k0 < 64) ? 1.f : -1.f; const f32x4 c0 = *(const f32x4*)src * sg, c1 = *(const f32x4*)(src + 4) * sg;
        u32x4 pw; pw.x = pk2(c0.x, c0.y); pw.y = pk2(c0.z, c0.w); pw.z = pk2(c1.x, c1.y); pw.w = pk2(c1.z, c1.w); cfr[ks] = __builtin_bit_cast(bf16x8, pw); }
    float sre = 0.f, sim = 0.f;
    if (seq >= 16) { const size_t si = ((size_t)(((seq - 16) * 4 + l) * 2 + dir) * 16 + g) * 64 + lane; sre = a.in[6][si]; sim = a.in[7][si]; }
    const bf16* U = (const bf16*)(a.ws + WS_UU) + (size_t)mbase * 256 + g * 16;
    float* Y = (float*)(a.ws + WS_H) + (size_t)dir * MT * 256 + (size_t)mbase * 256 + g * 16;
    if (!SPLIT) {
        s5_run<true>(wl, U, Y, L, dir, 0, L, bfr, cfr, ar, ai, sre, sim, lane);
        if (seq < 16) { const size_t so = ((size_t)((seq * 4 + l) * 2 + dir) * 16 + g) * 64 + lane; a.out[O_SRE + so] = sre; a.out[O_SIM + so] = sim; }
    } else {
        const int c_lo = w * 512, c_hi = c_lo + 512;
        float er = 0.f, ei = 0.f;
        if (w < 7) s5_run<false>(wl, U, Y, L, dir, c_lo, c_hi, bfr, cfr, ar, ai, er, ei, lane);
        xl[w * 128 + lane] = er; xl[w * 128 + 64 + lane] = ei;
        __syncthreads();
        float pr = ar, pi = ai;
#pragma unroll
        for (int q = 0; q < 9; ++q) { const float t_r = pr * pr - pi * pi, t_i = 2.f * pr * pi; pr = t_r; pi = t_i; }
        for (int j = 0; j < w; ++j) { const float e_r = xl[j * 128 + lane], e_i = xl[j * 128 + 64 + lane]; const float n_r = fmaf(pr, sre, fmaf(-pi, sim, e_r)), n_i = fmaf(pr, sim, fmaf(pi, sre, e_i)); sre = n_r; sim = n_i; }
        s5_run<true>(wl, U, Y, L, dir, c_lo, c_hi, bfr, cfr, ar, ai, sre, sim, lane);
        __syncthreads();
    }
}

DI void glu_item(const Args& a, LAS unsigned char* lds, int l, int item, int tid, int lane, int w) {
    const int m0 = item * 32;
    LAS bf16* YG = (LAS bf16*)lds;
    LAS float* YF32 = (LAS float*)(lds + 16896);
    const bf16* UU = (const bf16*)(a.ws + WS_UU); const float* YF = (const float*)(a.ws + WS_H); const float* YB = YF + (size_t)MT * 256;
    bf16* MIX = (bf16*)(a.ws + WS_PROJ);
    const int row = tid >> 4, c0 = (tid & 15) * 16; const size_t gro = (size_t)(m0 + row) * 256 + c0;
#pragma unroll
    for (int q = 0; q < 4; ++q) { const u32x2 ur = *(const u32x2*)(UU + gro + q * 4); const f32x4 yf = *(const f32x4*)(YF + gro + q * 4), yb = *(const f32x4*)(YB + gro + q * 4), dd = *(const f32x4*)(a.in[29] + l * 256 + c0 + q * 4);
        f32x4 y; y.x = dd.x * bflo(ur.x) + yf.x + yb.x; y.y = dd.y * bfhi(ur.x) + yf.y + yb.y; y.z = dd.z * bflo(ur.y) + yf.z + yb.z; y.w = dd.w * bfhi(ur.y) + yf.w + yb.w;
#pragma unroll
        for (int e = 0; e < 4; ++e) { const float v = y[e]; const float z = 0.7978845608028654f * (v + 0.044715f * v * v * v); const float th = 1.f - 2.f * __builtin_amdgcn_rcpf(1.f + __expf(2.f * z)); y[e] = 0.5f * v * (1.f + th); }
        *(LAS f32x4*)(YF32 + row * 260 + c0 + q * 4) = y; u32x2 o; o.x = pk2(y.x, y.y); o.y = pk2(y.z, y.w); *(LAS u32x2*)(YG + row * 264 + c0 + q * 4) = o; }
    __syncthreads();
    const int n16 = lane & 15, kq = lane >> 4;
    { const bf16* W = (const bf16*)(a.ws + WS_WGLU) + (size_t)l * 256 * 256 + (size_t)(w * 32 + n16) * 256 + 8 * kq;
      f32x4 acc[2][2];
#pragma unroll
      for (int c = 0; c < 2; ++c) { acc[c][0] = (f32x4){0.f, 0.f, 0.f, 0.f}; acc[c][1] = (f32x4){0.f, 0.f, 0.f, 0.f}; }
      small_gemm<2, 8, 264, 256>(YG, W, item + w, acc, n16, kq);
#pragma unroll
      for (int c = 0; c < 2; ++c) { const int col = w * 32 + c * 16 + n16; const float bg = a.in[31][l * 256 + col];
#pragma unroll
          for (int rb = 0; rb < 2; ++rb)
#pragma unroll
              for (int i = 0; i < 4; ++i) { const int rw = 16 * rb + 4 * kq + i; const float z = acc[c][rb][i] + bg; const float yv = YF32[rw * 260 + col]; YF32[rw * 260 + col] = yv * __builtin_amdgcn_rcpf(1.f + __expf(-z)); } } }
    __syncthreads();
    { u32x4 o0, o1; const LAS float* sp = YF32 + row * 260 + c0; const f32x4 a0 = *(const LAS f32x4*)sp, a1 = *(const LAS f32x4*)(sp + 4), a2 = *(const LAS f32x4*)(sp + 8), a3 = *(const LAS f32x4*)(sp + 12);
      o0.x = pk2(a0.x, a0.y); o0.y = pk2(a0.z, a0.w); o0.z = pk2(a1.x, a1.y); o0.w = pk2(a1.z, a1.w); o1.x = pk2(a2.x, a2.y); o1.y = pk2(a2.z, a2.w); o1.z = pk2(a3.x, a3.y); o1.w = pk2(a3.z, a3.w);
      bf16* dst = MIX + (size_t)(m0 + row) * 1024 + 768 + c0; *(u32x4*)dst = o0; *(u32x4*)(dst + 8) = o1; }
    __syncthreads();
}

typedef __attribute__((address_space(1))) unsigned gu32;
#define XB_TMO      128
#define XB_XCNT(j)  (256  + 64 * (j))
#define XB_XSUB(j)  (1280 + 64 * (j))
#define XB_XGEN(j)  (2304 + 64 * (j))
#define XB_TOP      3328
#define XB_TOPGEN   3392
#define XCD_BAR_WORDS 3456
#define XB_SPIN_CAP (1u << 18)

__device__ __forceinline__ unsigned xb_ld(unsigned* p)              { return __hip_atomic_load(p, __ATOMIC_RELAXED, __HIP_MEMORY_SCOPE_AGENT); }
__device__ __forceinline__ unsigned xb_add(unsigned* p, unsigned v) { return __hip_atomic_fetch_add(p, v, __ATOMIC_RELAXED, __HIP_MEMORY_SCOPE_AGENT); }
__device__ __forceinline__ unsigned xb_xcc_id() { return (unsigned)__builtin_amdgcn_s_getreg((3 << 11) | 20) & 0xFu; }
#define XB_SPIN(cond, bar) do { unsigned _sp = 0; while (cond) { __builtin_amdgcn_s_sleep(1); \
    if ((++_sp & 255u) == 0u) { if (xb_ld(&(bar)[XB_TMO])) break; if (_sp > XB_SPIN_CAP) { atomicAdd(&(bar)[XB_TMO], 1u); break; } } } } while (0)

struct XcdBarrier {
    unsigned* bar; unsigned x;
    volatile LAS unsigned* st;
};

__device__ __forceinline__ XcdBarrier xcd_barrier_post(unsigned* bar, volatile LAS unsigned* st) {
    XcdBarrier b; b.bar = bar; b.x = xb_xcc_id(); b.st = st;
    if (threadIdx.x == 0) (void)xb_add(&bar[XB_XCNT(b.x)], 1u);
    return b;
}
__device__ __forceinline__ void xcd_barrier_complete(unsigned* bar, unsigned x, unsigned& nloc, unsigned& nx) {
    const unsigned G = gridDim.x * gridDim.y * gridDim.z;
    unsigned sum, cnt, mine, sp = 0u;
    for (;;) {
        sum = 0u; cnt = 0u; mine = 0u;
#pragma unroll
        for (unsigned j = 0; j < 16; ++j) { const unsigned c = xb_ld(&bar[XB_XCNT(j)]); sum += c; cnt += (c > 0u) ? 1u : 0u; mine = (j == x) ? c : mine; }
        if (sum == G) break;
        __builtin_amdgcn_s_sleep(1);
        if ((++sp & 255u) == 0u) { if (xb_ld(&bar[XB_TMO])) break; if (sp > XB_SPIN_CAP) { atomicAdd(&bar[XB_TMO], 1u); break; } }
    }
    nloc = mine > 0u ? mine : 1u; nx = cnt > 0u ? cnt : 1u;
}

__device__ __forceinline__ void xcd_barrier(const XcdBarrier& b) {
    asm volatile("s_waitcnt vmcnt(0)" ::: "memory");
    __syncthreads();
    if (threadIdx.x == 0) {
        unsigned* bar = b.bar;
        __builtin_amdgcn_s_waitcnt(0);
        unsigned nloc = b.st[0], nx = b.st[1];
        if (nloc == 0u) { xcd_barrier_complete(bar, b.x, nloc, nx); b.st[0] = nloc; b.st[1] = nx; }
        const unsigned old = xb_add(&bar[XB_XSUB(b.x)], 1u);
        const unsigned gen = old / nloc;
        if (old + 1u == (gen + 1u) * nloc) {
            __builtin_amdgcn_fence(__ATOMIC_RELEASE, "agent");
            asm volatile("s_waitcnt vmcnt(0)" ::: "memory");
            const unsigned og = xb_add(&bar[XB_TOP], 1u);
            const unsigned tg = og / nx;
            if (og + 1u == (tg + 1u) * nx) xb_add(&bar[XB_TOPGEN], 1u);
            else XB_SPIN(xb_ld(&bar[XB_TOPGEN]) == tg, bar);
            __builtin_amdgcn_fence(__ATOMIC_ACQUIRE, "agent");
            xb_add(&bar[XB_XGEN(b.x)], 1u);
            asm volatile("s_waitcnt vmcnt(0)" ::: "memory");
        } else {
            XB_SPIN(xb_ld(&bar[XB_XGEN(b.x)]) == gen, bar);
            __builtin_amdgcn_fence(__ATOMIC_ACQUIRE, "agent");
            asm volatile("s_waitcnt vmcnt(0)" ::: "memory");
        }
    }
    __syncthreads();
}

#define ATT_UNITS(ABLV) \
            for (int uu = vcu; uu < 256 + 1536; uu += G) { \
                int seq, h, m0, Lk; bool mla; size_t kr0; \
                if (uu < 256) { const int s = uu; if ((s & 3) == 0) continue; const int pu = (s >> 2) * 3 + (s & 3) - 1; seq = pu / 12; const int hx = pu % 12; mla = hx >= 6; h = mla ? hx - 6 : hx; m0 = seq * 256; Lk = 256; kr0 = (size_t)m0; } \
                else { const int u = uu - 256; const int pass = u >> 8, c = u & 255, idx = (pass >> 1) * 256 + c; const int b = idx / 96; h = (idx % 96) >> 4; const int qb = idx & 15; \
                       seq = 16 + b; mla = (pass & 1) != 0; m0 = MP + b * 4096 + qb * 256; Lk = LKS; kr0 = (size_t)MP + (size_t)b * LKS; } \
                if (!mla) attn_unit<64, ABLV>(lds, QA + (size_t)m0 * 384 + h * 64, 384, KA + kr0 * 128 + (h / 3) * 64, 128, VTA + vtbase(seq, 128) + (size_t)(h / 3) * 64 * Lk, Lk, MIX + (size_t)m0 * 1024 + h * 64, tid); \
                else attn_unit<96, ABLV>(lds, QB + (size_t)m0 * 576 + h * 96, 576, KB + kr0 * 576 + h * 96, 576, VTB + vtbase(seq, 384) + (size_t)h * 64 * Lk, Lk, MIX + (size_t)m0 * 1024 + 384 + h * 64, tid); \
            }
__global__ void __launch_bounds__(512, 2) mega(Args a) {
    extern __shared__ __attribute__((aligned(16))) unsigned char lds_raw[];
    LAS unsigned char* lds = (LAS unsigned char*)lds_raw;
    cg::grid_group grid = cg::this_grid();
    const int G = gridDim.x, bx = blockIdx.x;
#define LAUNDER_TID int tid = threadIdx.x; asm volatile("" : "+v"(tid)); const int lane = tid & 63, w = __builtin_amdgcn_readfirstlane(tid >> 6); const int gw = vcu * 8 + w
    const int vcu = (G % 8 == 0) ? (bx % 8) * (G / 8) + bx / 8 : bx;
    const int ngw = G * 8;
    int ph = 0;
    volatile LAS unsigned* bar_st = (volatile LAS unsigned*)(lds + LDS_BYTES - 64);
    if (threadIdx.x < 2) bar_st[threadIdx.x] = 0u;
    __syncthreads();
    XcdBarrier xbar = xcd_barrier_post((unsigned*)(a.ws + WS_BAR), bar_st);
#ifndef PMASK
#define PMASK 0xFFFF
#endif
#define PH_ON (a.ph_lo <= ph && ph < a.ph_hi)
#define PM(b) ((PMASK >> (b)) & 1)
#ifndef REPMASK
#define REPMASK 0
#endif
#define REPS(b) (((REPMASK >> (b)) & 1) ? 2 : 1)
#define PH_END do { if (a.ph_lo <= ph && ph + 1 < a.ph_hi) { if (ph == 0) grid.sync(); else xcd_barrier(xbar); } ++ph; } while (0)
    float* X = a.out;
    bf16* H = (bf16*)(a.ws + WS_H);
    const float* MOD = (const float*)(a.ws + WS_MOD);

    if (PM(0) && PH_ON) for (int rep = 0; rep < REPS(0); ++rep) { LAUNDER_TID;
        p0_convert(a, lds, gw, ngw, w, lane);
        __syncthreads();
        for (int it = bx; it < 768; it += G) ada_partial_item(a, lds, it, tid);
    }
    PH_END;
    if (PM(1) && PH_ON) for (int rep = 0; rep < REPS(1); ++rep) { LAUNDER_TID;
        const float* P = (const float*)(a.ws + WS_MODP); float* Mo = (float*)(a.ws + WS_MOD);
        for (int i = bx * 512 + tid; i < NLAYER * 9 * 6144; i += G * 512) { const int l = i / (9 * 6144), r = i % (9 * 6144), n = r % 6144; float s = a.in[13][l * 6144 + n];
#pragma unroll
            for (int ks = 0; ks < 8; ++ks) s += P[(size_t)(l * 8 + ks) * 9 * 6144 + r];
            Mo[i] = s; }
    }
    PH_END;
    if (PM(2) && PH_ON) for (int rep = 0; rep < REPS(2); ++rep) { LAUNDER_TID; norm_rows(a.in[0], a.in[1], a.in[10], MOD, 0, 1024, H, gw, ngw, lane); }
    PH_END;

#pragma unroll 1
    for (int l = 0; l < NLAYER; ++l) {
        const float* mod_l = MOD + (size_t)l * 9 * 6144;
        if (PM(3) && PH_ON) for (int rep = 0; rep < REPS(3); ++rep) {
            pg8::Gemm g{H, (const bf16*)(a.ws + WS_WIN) + (size_t)l * 1536 * 1024, MT, NINP, 1024}; pg8::StaticOrder S; S.init(MT, NINP, G, bx);
            pg8::EpiBf16<0> E{(bf16*)(a.ws + WS_PROJ), NINP, nullptr, 0, 0, 1.f};
            pg8::gemm_phase<pg8::EpiBf16<0>, pg8::StaticOrder, true, true>(lds, g, S, E);
        }
        PH_END;
        if (PM(4) && PH_ON) for (int rep = 0; rep < REPS(4); ++rep) { LAUNDER_TID;
            post_tables(lds, tid); __syncthreads();
#ifdef PABLX
            for (int it = vcu; it < 1152 + 128; it += G) post_item<PABLX>(a, lds, l, it, tid, lane, w);
#endif
            for (int it = vcu; it < 1152 + 128; it += G) post_item<0>(a, lds, l, it, tid, lane, w);
        }
        PH_END;
        if (PM(5) && PH_ON) for (int rep = 0; rep < REPS(5); ++rep) { LAUNDER_TID;
            const bf16* QA = (const bf16*)(a.ws + WS_QA); const bf16* QB = (const bf16*)(a.ws + WS_QB); const bf16* KA = (const bf16*)(a.ws + WS_KA); const bf16* KB = (const bf16*)(a.ws + WS_KB);
            const bf16* VTA = (const bf16*)(a.ws + WS_VTA); const bf16* VTB = (const bf16*)(a.ws + WS_VTB); bf16* MIX = (bf16*)(a.ws + WS_PROJ);
            for (int s = vcu; s < 256; s += G) {
                s5_task<true>(a, (LAS float*)(lds + w * 16896), (LAS float*)(lds + 135168), l, 16 + (s >> 5), (s & 31) >> 1, s & 1, lane, w);
                if (w < 2) { const int id = s * 2 + w; s5_task<false>(a, (LAS float*)(lds + w * 16896), (LAS float*)(lds + 135168), l, id >> 5, (id & 31) >> 1, id & 1, lane, w); }
            }
            __syncthreads();
            ATT_UNITS(0)
#ifdef ABLX
            __syncthreads();
            ATT_UNITS(ABLX)
#endif
        }
        PH_END;
        if (PM(6) && PH_ON) for (int rep = 0; rep < REPS(6); ++rep) { LAUNDER_TID; for (int it = vcu; it < 1152; it += G) glu_item(a, lds, l, it, tid, lane, w); }
        PH_END;
        if (PM(7) && PH_ON) {
            pg8::Gemm g{(const bf16*)(a.ws + WS_PROJ), (const bf16*)(a.ws + WS_WOUT) + (size_t)l * 1024 * 1024, MT, 1024, 1024}; pg8::StaticOrder S; S.init(MT, 1024, G, bx);
            EpiRes E{l == 0 ? a.in[0] : X, l == 0 ? a.in[1] : X + (size_t)MP * 1024, X, mod_l + 2048};
            pg8::gemm_phase<EpiRes, pg8::StaticOrder, true, true>(lds, g, S, E);
        }
        PH_END;
        if (PM(8) && PH_ON) for (int rep = 0; rep < REPS(8); ++rep) { LAUNDER_TID; norm_rows(X, X + (size_t)MP * 1024, a.in[11] + l * 1024, mod_l, 3072, 4096, H, gw, ngw, lane); }
        PH_END;
        if (PM(9) && PH_ON) for (int rep = 0; rep < REPS(9); ++rep) {
            pg8::Gemm g{H, (const bf16*)(a.ws + WS_WF1) + (size_t)l * 5632 * 1024, MT, NF1, 1024}; pg8::StaticOrder S; S.init(MT, NF1, G, bx);
            EpiSwiglu E{(bf16*)(a.ws + WS_HDN)};
            pg8::gemm_phase<EpiSwiglu, pg8::StaticOrder, true, true>(lds, g, S, E);
        }
        PH_END;
        if (PM(10) && PH_ON) {
            pg8::Gemm g{(const bf16*)(a.ws + WS_HDN), (const bf16*)(a.ws + WS_WF2) + (size_t)l * 1024 * 2816, MT, 1024, DFF}; pg8::StaticOrder S; S.init(MT, 1024, G, bx);
            EpiRes E{X, X + (size_t)MP * 1024, X, mod_l + 5120};
            pg8::gemm_phase<EpiRes, pg8::StaticOrder, true, true>(lds, g, S, E);
        }
        PH_END;
        if (PM(11) && PH_ON) { LAUNDER_TID;
            if (l + 1 < NLAYER) norm_rows(X, X + (size_t)MP * 1024, a.in[10] + (l + 1) * 1024, mod_l + 9 * 6144, 0, 1024, H, gw, ngw, lane);
            else final_norm_rows(X, a.in[35], gw, ngw, lane);
        }
        PH_END;
    }
}

extern "C" void kernel_launch(void* const* d_in, const int* in_sizes, int n_in, void* d_out, int out_size, void* d_ws, size_t ws_size, hipStream_t stream) {
    static int grid = 0;
    if (grid == 0) {
        if (n_in != 36 || ws_size < WS_TOTAL) { fprintf(stderr, "kernel_launch: unexpected n_in %d / ws %zu (need %zu)\n", n_in, ws_size, (size_t)WS_TOTAL); grid = -1; return; }
        int dev = 0, cus = 0, per_cu = 0;
        hipGetDevice(&dev); hipDeviceGetAttribute(&cus, hipDeviceAttributeMultiprocessorCount, dev);
        if (hipFuncSetAttribute((const void*)mega, hipFuncAttributeMaxDynamicSharedMemorySize, LDS_BYTES) != hipSuccess) fprintf(stderr, "kernel_launch: hipFuncSetAttribute failed\n");
        if (hipOccupancyMaxActiveBlocksPerMultiprocessor(&per_cu, (const void*)mega, 512, LDS_BYTES) != hipSuccess || per_cu < 1) { fprintf(stderr, "kernel_launch: occupancy query says %d\n", per_cu); per_cu = 1; }
        (void)hipGetLastError();
        grid = cus;
    }
    if (grid < 0) return;
    Args a{};
    for (int i = 0; i < 36; ++i) a.in[i] = (const float*)d_in[i];
    a.out = (float*)d_out; a.ws = (unsigned char*)d_ws;
#if defined(MK_MULTI)
    for (int p = 0; p < NPHASE; ++p) { a.ph_lo = p; a.ph_hi = p + 1; hipLaunchKernelGGL(mega, dim3(grid), dim3(512), LDS_BYTES, stream, a); }
#else
    a.ph_lo = 0; a.ph_hi = NPHASE;
    if (hipMemsetAsync((char*)d_ws + WS_BAR, 0, 16384, stream) != hipSuccess) fprintf(stderr, "kernel_launch: memset failed\n");
    void* args[] = {&a};
    hipError_t e = hipLaunchCooperativeKernel((const void*)mega, dim3(grid), dim3(512), args, LDS_BYTES, stream);
    if (e != hipSuccess) fprintf(stderr, "kernel_launch: cooperative launch failed: %s (grid %d)\n", hipGetErrorString(e), grid);
#endif
}
```

```cpp
#define WGM_WIDE 4
#define WGM_NARROW 1
#include <hip/hip_runtime.h>
#include <hip/hip_cooperative_groups.h>
#include <cstdio>
#include <cstdint>
namespace cg = cooperative_groups;
namespace pg8 {
#define PG8_LAS __attribute__((address_space(3)))
typedef unsigned short bf16_t;
typedef short bf16x8 __attribute__((ext_vector_type(8)));
typedef float f32x4 __attribute__((ext_vector_type(4)));
typedef unsigned u32x4 __attribute__((ext_vector_type(4)));
constexpr int BM = 256, BK = 64, HALF = 128, HTB = HALF * BK * 2  , STAGE_BYTES = 8 * HTB, NXCD = 8, WGM = 8;
#ifndef WGM_WIDE
#define WGM_WIDE 2
#endif
#ifndef WGM_NARROW
#define WGM_NARROW 8
#endif

__host__ __device__ __forceinline__ int lds_byte(int r, int c) { const int st = (r >> 4) * 2 + (c >> 5), rr = r & 15, cc = c & 31, ob = rr * 64 + cc * 2; return st * 1024 + (ob ^ (((ob >> 9) & 1) << 5)); }
__host__ __device__ __forceinline__ void stage_rc(int b, int& R, int& C) { const int st = b / 1024, sb = b % 1024, swz = sb ^ (((sb >> 9) & 1) << 5); R = (st >> 1) * 16 + swz / 64; C = (st & 1) * 32 + (swz % 64) / 2; }
__host__ __device__ __forceinline__ int perm32(int rho) { const int n = rho >> 4, i = rho & 15; return 8 * (i >> 2) + 4 * n + (i & 3); }

struct Unit { int pm, pn; };
struct Gemm { const bf16_t* A; const bf16_t* Bt; int M, N, K; };

struct StaticOrder {
    int nM, nN, nwg, G, c, wgm;
    __host__ __device__ void init(int M, int N, int G_, int c_) { nM = M / BM; nN = N / BM; nwg = nM * nN; G = G_; c = c_; wgm = (nN >= 16) ? WGM_WIDE : WGM_NARROW; }
    __host__ __device__ bool next(int i, Unit& u) const {
        const long L = (long)i * G + c; if (L >= nwg) return false;
        int wgid = (int)L; { const int q = nwg / NXCD, r = nwg % NXCD, xcd = wgid % NXCD, off = wgid / NXCD; wgid = (xcd < r ? xcd * (q + 1) : r * (q + 1) + (xcd - r) * q) + off; }
        const int nig = wgm * nN, gid = wgid / nig, fm = gid * wgm, gsz = (nM - fm) < wgm ? (nM - fm) : wgm;
        u.pm = fm + ((wgid % nig) % gsz); u.pn = (wgid % nig) / gsz; return true;
    }
    __device__ __forceinline__ void a_ready(const Unit&) const {}
    __device__ __forceinline__ void done(const Unit&) const {}
};

__device__ __forceinline__ unsigned cvt_pk_bf16(float lo, float hi) { unsigned r; asm volatile("v_cvt_pk_bf16_f32 %0, %1, %2" : "=v"(r) : "v"(lo), "v"(hi)); return r; }
typedef float f32x2 __attribute__((ext_vector_type(2)));
__device__ __forceinline__ f32x2 gelu_pk(f32x2 v) {
    const f32x2 av = __builtin_elementwise_abs(v), d = av * 0.2316418882f + 1.0f;
    f32x2 t; t.x = __builtin_amdgcn_rcpf(d.x); t.y = __builtin_amdgcn_rcpf(d.y);
    f32x2 q = t * 0.5307027145f + (-0.7265760135f); q = q * t + 0.7107068705f; q = q * t + (-0.142248368f); q = q * t + 0.127414796f; q = q * t;
    const f32x2 s = (v * v) * (-0.72134752044f);
    f32x2 e; e.x = __builtin_amdgcn_exp2f(s.x); e.y = __builtin_amdgcn_exp2f(s.y);
    const f32x2 m = v * (q * e), r = v - m;
    f32x2 o; o.x = v.x < 0.f ? m.x : r.x; o.y = v.y < 0.f ? m.y : r.y; return o;
}

template <int ACT  > struct EpiBf16 {
    static constexpr bool PERM = true, AFTER_DRAIN = false; static_assert(ACT == 0 || ACT == 1, "EpiBf16: ACT is 0 (none) or 1 (gelu_pk)");
    bf16_t* O; int ldc; const float* bias; int split_cols; size_t split_stride; float scale0;
    __device__ __forceinline__ void operator()(const f32x4 (&acc)[2][2][4][2], const Unit& u, int wr, int wc, int fr, int fq) const {
        const int row0 = u.pm * BM + wr * 64 + fr; int colt = u.pn * BM; bf16_t* base = O;
        float sc = 1.f; if (split_cols) { const int t = colt / split_cols; base += (size_t)t * split_stride; colt -= t * split_cols; if (t == 0) sc = scale0; }
        const int col0 = colt + wc * 32 + 8 * fq, bcol0 = u.pn * BM + wc * 32 + 8 * fq;
        f32x4 bv[2][2];
#pragma unroll
        for (int bj = 0; bj < 2; ++bj)
#pragma unroll
            for (int n = 0; n < 2; ++n) bv[bj][n] = bias ? *(const f32x4*)(bias + bcol0 + bj * HALF + 4 * n) : (f32x4){0.f, 0.f, 0.f, 0.f};
#pragma unroll
        for (int ai = 0; ai < 2; ++ai)
#pragma unroll
            for (int m = 0; m < 4; ++m) { bf16_t* rowp = base + (size_t)(row0 + ai * HALF + m * 16) * ldc + col0;
#pragma unroll
                for (int bj = 0; bj < 2; ++bj) { f32x4 v0 = acc[ai][bj][m][0] + bv[bj][0], v1 = acc[ai][bj][m][1] + bv[bj][1];
                    if (ACT == 1) { f32x2 a = gelu_pk((f32x2){v0[0], v0[1]}), b = gelu_pk((f32x2){v0[2], v0[3]}), c = gelu_pk((f32x2){v1[0], v1[1]}), d = gelu_pk((f32x2){v1[2], v1[3]});
                        v0 = (f32x4){a.x, a.y, b.x, b.y}; v1 = (f32x4){c.x, c.y, d.x, d.y}; }
                    v0 = v0 * sc; v1 = v1 * sc; u32x4 w; w.x = cvt_pk_bf16(v0[0], v0[1]); w.y = cvt_pk_bf16(v0[2], v0[3]); w.z = cvt_pk_bf16(v1[0], v1[1]); w.w = cvt_pk_bf16(v1[2], v1[3]);
                    *(u32x4*)(rowp + bj * HALF) = w; } }
    }
};
template <class Epi, class Sched, bool ALIGN_EPI = false, bool SP2 = false>
__device__ __forceinline__ void gemm_phase(PG8_LAS unsigned char* lds, const Gemm g, const Sched& S, const Epi& E) {
    int tid_ = threadIdx.x; asm volatile("" : "+v"(tid_));
    const int tid = tid_, wid = __builtin_amdgcn_readfirstlane(tid >> 6), lane = tid & 63, wr = wid >> 2, wc = wid & 3, fr = lane & 15, fq = lane >> 4;
    const int K = g.K, nt = K / BK;
    unsigned voffA[2], voffB[2];
#pragma unroll
    for (int i = 0; i < 2; ++i) { int R, C; stage_rc(tid * 16 + i * 8192, R, C); const int Rb = Epi::PERM ? ((R & ~31) + perm32(R & 31)) : R;
        voffA[i] = (unsigned)(R * K + C) * 2u; voffB[i] = (unsigned)(Rb * K + C) * 2u; }
    const size_t kstep = (size_t)(BK * 2);
    const size_t hstep = (size_t)HALF * K * 2;
    const size_t tstep = 2 * hstep;
    const unsigned ldsw = (unsigned)wid * 1024u;
    const int aoff = lds_byte(wr * 64 + fr, fq * 8), boff = lds_byte(wc * 32 + fr, fq * 8);
#define PG8_SA(b, h) (((b) * 2 + (h)) * HTB)
#define PG8_SB(b, h) ((4 + (b) * 2 + (h)) * HTB)
#define PG8_STAGE(bufoff, gbase, voff) do { _Pragma("unroll") for (int _i = 0; _i < 2; ++_i) \
        __builtin_amdgcn_global_load_lds((const unsigned*)((const char*)(gbase) + (voff)[_i]), (PG8_LAS unsigned*)(lds + (bufoff) + ldsw + _i * 8192), 16, 0, 0); } while (0)
#define PG8_LDA(dst, b, h) do { _Pragma("unroll") for (int m = 0; m < 4; ++m) _Pragma("unroll") for (int k = 0; k < 2; ++k) dst[m][k] = *(const PG8_LAS bf16x8*)(lds + PG8_SA(b, h) + aoff + m * 2048 + k * 1024); } while (0)
#define PG8_LDB(dst, b, h) do { _Pragma("unroll") for (int n = 0; n < 2; ++n) _Pragma("unroll") for (int k = 0; k < 2; ++k) dst[n][k] = *(const PG8_LAS bf16x8*)(lds + PG8_SB(b, h) + boff + n * 2048 + k * 1024); } while (0)
#define PG8_MMA(ai, bj, At, Bt) do { __builtin_amdgcn_s_setprio(1); _Pragma("unroll") for (int m = 0; m < 4; ++m) _Pragma("unroll") for (int n = 0; n < 2; ++n) _Pragma("unroll") for (int k = 0; k < 2; ++k) \
        acc[ai][bj][m][n] = __builtin_amdgcn_mfma_f32_16x16x32_bf16(Bt[n][k], At[m][k], acc[ai][bj][m][n], 0, 0, 0); __builtin_amdgcn_s_setprio(0); } while (0)
#define PG8_WAIT_V(n) asm volatile("s_waitcnt vmcnt(" #n ")" ::: "memory")
#define PG8_WAIT_L(n) asm volatile("s_waitcnt lgkmcnt(" #n ")" ::: "memory")
#define PG8_BAR __builtin_amdgcn_s_barrier()
#define PG8_SCHED __builtin_amdgcn_sched_barrier(0)
    Unit cur, nxt; int ui = 0;
    if (!S.next(0, cur)) return;
    f32x4 acc[2][2][4][2];
#pragma unroll
    for (int a = 0; a < 2; ++a)
#pragma unroll
        for (int b = 0; b < 2; ++b)
#pragma unroll
            for (int m = 0; m < 4; ++m)
#pragma unroll
                for (int n = 0; n < 2; ++n) acc[a][b][m][n] = (f32x4){0.f, 0.f, 0.f, 0.f};
    bf16x8 At[4][2], B0[2][2], B1[2][2];
    const char* cA = (const char*)g.A + (size_t)cur.pm * tstep; const char* cB = (const char*)g.Bt + (size_t)cur.pn * tstep;
    S.a_ready(cur);
    if constexpr (SP2) {
        PG8_STAGE(PG8_SB(0, 0), cB, voffB); PG8_STAGE(PG8_SB(0, 1), cB + hstep, voffB); PG8_STAGE(PG8_SA(0, 0), cA, voffA); PG8_STAGE(PG8_SA(0, 1), cA + hstep, voffA);
        if (wr == 1) PG8_BAR;
        PG8_WAIT_V(2); PG8_BAR;
        PG8_STAGE(PG8_SB(1, 0), cB + kstep, voffB); PG8_STAGE(PG8_SA(1, 0), cA + kstep, voffA); PG8_STAGE(PG8_SB(1, 1), cB + hstep + kstep, voffB);
        PG8_WAIT_V(6); PG8_BAR;
    } else {
        PG8_STAGE(PG8_SB(0, 0), cB, voffB); PG8_STAGE(PG8_SA(0, 0), cA, voffA); PG8_STAGE(PG8_SB(0, 1), cB + hstep, voffB); PG8_STAGE(PG8_SA(0, 1), cA + hstep, voffA);
        if (wr == 1) PG8_BAR;
        PG8_WAIT_V(4); PG8_BAR;
        PG8_STAGE(PG8_SB(1, 0), cB + kstep, voffB); PG8_STAGE(PG8_SA(1, 0), cA + kstep, voffA); PG8_STAGE(PG8_SB(1, 1), cB + hstep + kstep, voffB);
        PG8_WAIT_V(6); PG8_BAR;
    }
    for (;;) {
        const bool has_next = S.next(ui + 1, nxt);
        const char* nA = has_next ? (const char*)g.A + (size_t)nxt.pm * tstep : cA; const char* nB = has_next ? (const char*)g.Bt + (size_t)nxt.pn * tstep : cB;
        for (int t = 0; t < nt; t += 2) {
            const bool last = (t == nt - 2);
            const char* a1 = cA + (size_t)(t + 1) * kstep;
            const char* a2 = last ? nA : cA + (size_t)(t + 2) * kstep; const char* b2 = last ? nB : cB + (size_t)(t + 2) * kstep;
            const char* a3 = a2 + kstep; const char* b3 = b2 + kstep;
            if (last && has_next) S.a_ready(nxt);
            if constexpr (SP2) {
            PG8_LDB(B0, 0, 0); PG8_LDB(B1, 0, 1); PG8_SCHED; PG8_LDA(At, 0, 0); PG8_STAGE(PG8_SA(1, 1), a1 + hstep, voffA);
            PG8_WAIT_V(8); PG8_WAIT_L(0); PG8_BAR; PG8_MMA(0, 0, At, B0); PG8_MMA(0, 1, At, B1); PG8_BAR; PG8_SCHED;
            PG8_LDA(At, 0, 1); PG8_STAGE(PG8_SB(0, 0), b2, voffB); PG8_STAGE(PG8_SB(0, 1), b2 + hstep, voffB); PG8_STAGE(PG8_SA(0, 0), a2, voffA);
            PG8_WAIT_V(8); PG8_WAIT_L(0); PG8_BAR; PG8_MMA(1, 0, At, B0); PG8_MMA(1, 1, At, B1); PG8_BAR; PG8_SCHED;
            PG8_LDB(B0, 1, 0); PG8_LDB(B1, 1, 1); PG8_SCHED; PG8_LDA(At, 1, 0); PG8_STAGE(PG8_SA(0, 1), a2 + hstep, voffA);
            PG8_WAIT_V(8); PG8_WAIT_L(0); PG8_BAR; PG8_MMA(0, 0, At, B0); PG8_MMA(0, 1, At, B1); PG8_BAR; PG8_SCHED;
            PG8_LDA(At, 1, 1); PG8_STAGE(PG8_SB(1, 0), b3, voffB); PG8_STAGE(PG8_SB(1, 1), b3 + hstep, voffB); PG8_STAGE(PG8_SA(1, 0), a3, voffA);
            PG8_WAIT_V(8); PG8_WAIT_L(0); PG8_BAR; PG8_MMA(1, 0, At, B0); PG8_MMA(1, 1, At, B1); PG8_BAR; PG8_SCHED;
            } else {
            PG8_LDB(B0, 0, 0); PG8_SCHED; PG8_LDA(At, 0, 0); PG8_STAGE(PG8_SA(1, 1), a1 + hstep, voffA);
            PG8_WAIT_L(8); PG8_BAR; PG8_WAIT_L(0); PG8_MMA(0, 0, At, B0); PG8_BAR; PG8_SCHED;
            PG8_LDB(B1, 0, 1); PG8_STAGE(PG8_SB(0, 0), b2, voffB);
            PG8_BAR; PG8_WAIT_L(0); PG8_MMA(0, 1, At, B1); PG8_BAR;
            PG8_LDA(At, 0, 1); PG8_STAGE(PG8_SA(0, 0), a2, voffA);
            PG8_BAR; PG8_WAIT_L(0); PG8_MMA(1, 0, At, B0); PG8_BAR; PG8_SCHED;
            PG8_STAGE(PG8_SB(0, 1), b2 + hstep, voffB);
            PG8_WAIT_V(6); PG8_BAR; PG8_MMA(1, 1, At, B1); PG8_BAR;
            PG8_LDB(B0, 1, 0); PG8_SCHED; PG8_LDA(At, 1, 0); PG8_STAGE(PG8_SA(0, 1), a2 + hstep, voffA);
            PG8_WAIT_L(8); PG8_BAR; PG8_WAIT_L(0); PG8_MMA(0, 0, At, B0); PG8_BAR; PG8_SCHED;
            PG8_LDB(B1, 1, 1); PG8_STAGE(PG8_SB(1, 0), b3, voffB);
            PG8_BAR; PG8_WAIT_L(0); PG8_MMA(0, 1, At, B1); PG8_BAR;
            PG8_LDA(At, 1, 1); PG8_STAGE(PG8_SA(1, 0), a3, voffA);
            PG8_BAR; PG8_WAIT_L(0); PG8_MMA(1, 0, At, B0); PG8_BAR; PG8_SCHED;
            PG8_STAGE(PG8_SB(1, 1), b3 + hstep, voffB);
            PG8_WAIT_V(6); PG8_BAR; PG8_MMA(1, 1, At, B1); PG8_BAR;
            }
        }
        if constexpr (ALIGN_EPI) { if (wr == 0) PG8_BAR; }
        if constexpr (!Epi::AFTER_DRAIN) { E(acc, cur, wr, wc, fr, fq); S.done(cur); }
        if (!has_next) break;
#pragma unroll
        for (int a = 0; a < 2; ++a)
#pragma unroll
            for (int b = 0; b < 2; ++b)
#pragma unroll
                for (int m = 0; m < 4; ++m)
#pragma unroll
                    for (int n = 0; n < 2; ++n) acc[a][b][m][n] = (f32x4){0.f, 0.f, 0.f, 0.f};
        cur = nxt; cA = nA; cB = nB; ++ui;
        if constexpr (ALIGN_EPI) { if (wr == 1) PG8_BAR; }
    }
    PG8_WAIT_V(0);
    if constexpr (!ALIGN_EPI) { if (wr == 0) PG8_BAR; }
    PG8_BAR;
    if constexpr (Epi::AFTER_DRAIN) { E.fused(acc, cur, wr, wc, fr, fq, lds, wid, lane); S.done(cur); }
#undef PG8_SA
#undef PG8_SB
#undef PG8_STAGE
#undef PG8_LDA
#undef PG8_LDB
#undef PG8_MMA
#undef PG8_WAIT_V
#undef PG8_WAIT_L
#undef PG8_BAR
#undef PG8_SCHED
}
}

#define DI __device__ __forceinline__
#define LAS __attribute__((address_space(3)))
typedef unsigned short bf16;
typedef short bf16x8 __attribute__((ext_vector_type(8)));
typedef float f32x4 __attribute__((ext_vector_type(4)));
typedef float f32x2 __attribute__((ext_vector_type(2)));
typedef float f32x16 __attribute__((ext_vector_type(16)));
typedef unsigned u32x4 __attribute__((ext_vector_type(4)));
typedef unsigned u32x2 __attribute__((ext_vector_type(2)));
typedef __bf16 bf16x2_t __attribute__((ext_vector_type(2)));

constexpr int DM = 1024, NPB = 16, NPL = 256, NSB = 8, NSL = 4096, PAST = 512, NLAYER = 4;
constexpr int MP = NPB * NPL;
constexpr int MS = NSB * NSL;
constexpr int MT = MP + MS;
constexpr int NINP = 1536, DFF = 2816, NF1 = 5632;
constexpr int LKS = NSL + PAST;
constexpr int KROWS = MP + NSB * LKS;
constexpr float EPS = 1e-6f;
constexpr float QSC_A = 0.125f * 1.4426950408889634f;
constexpr float QSC_B = 0.10206207261596575f * 1.4426950408889634f;
constexpr int LDS_BYTES = 147456;
constexpr int NPHASE = 3 + 9 * NLAYER;

constexpr size_t O_K = (size_t)MT * 1024, O_V = O_K + 2097152, O_CKV = O_V + 2097152, O_KR = O_CKV + 2097152, O_SRE = O_KR + 524288, O_SIM = O_SRE + 131072;

constexpr size_t WS_WIN = 0;
constexpr size_t WS_WOUT = WS_WIN + 4ull * 1536 * 1024 * 2;
constexpr size_t WS_WF1 = WS_WOUT + 4ull * 1024 * 1024 * 2;
constexpr size_t WS_WF2 = WS_WF1 + 4ull * 5632 * 1024 * 2;
constexpr size_t WS_WUQ = WS_WF2 + 4ull * 1024 * 2816 * 2;
constexpr size_t WS_WUKV = WS_WUQ + 4ull * 576 * 256 * 2;
constexpr size_t WS_WGLU = WS_WUKV + 4ull * 768 * 128 * 2;
constexpr size_t WS_MODP = WS_WGLU + 4ull * 256 * 256 * 2;
constexpr size_t WS_MOD = WS_MODP + 4ull * 8 * 9 * 6144 * 4;
constexpr size_t WS_H = WS_MOD + 4ull * 9 * 6144 * 4;
constexpr size_t WS_U0 = WS_H + (size_t)MT * 1024 * 2;
constexpr size_t WS_PROJ = WS_U0;
constexpr size_t WS_QA = WS_PROJ + (size_t)MT * 1536 * 2;
constexpr size_t WS_QB = WS_QA + (size_t)MT * 384 * 2;
constexpr size_t WS_KA = WS_QB + (size_t)MT * 576 * 2;
constexpr size_t WS_VTA = WS_KA + (size_t)KROWS * 128 * 2;
constexpr size_t WS_KB = WS_VTA + (size_t)KROWS * 128 * 2;
constexpr size_t WS_VTB = WS_KB + (size_t)KROWS * 576 * 2;
constexpr size_t WS_UU = WS_VTB + (size_t)KROWS * 384 * 2;
constexpr size_t WS_END = WS_UU + (size_t)MT * 256 * 2;
constexpr size_t WS_BAR = WS_END;
constexpr size_t WS_TOTAL = WS_END + 16384;
constexpr size_t WS_HDN = WS_U0;
static_assert(WS_HDN + (size_t)MT * 2816 * 2 <= WS_END, "hdn overlay");
static_assert(WS_TOTAL <= 536870912ull, "ws budget");

struct Args { const float* in[36]; float* out; unsigned char* ws; int ph_lo, ph_hi; };

DI unsigned pk2(float lo, float hi) { f32x2 v = {lo, hi}; bf16x2_t b = __builtin_convertvector(v, bf16x2_t); return __builtin_bit_cast(unsigned, b); }
DI unsigned short f2bf(float f) { return (unsigned short)(pk2(f, 0.f) & 0xffffu); }
DI float bf2f(unsigned short b) { return __uint_as_float(((unsigned)b) << 16); }
DI float bflo(unsigned u) { return __uint_as_float(u << 16); }
DI float bfhi(unsigned u) { return __uint_as_float(u & 0xffff0000u); }
DI float wave_sum(float v) {
#pragma unroll
    for (int o = 1; o < 64; o <<= 1) v += __shfl_xor(v, o);
    return v;
}
DI int crow(int r, int hi) { return (r & 3) + 8 * (r >> 2) + 4 * hi; }
DI int swap23(int r) { return (r & ~12) | ((r & 4) << 1) | ((r & 8) >> 1); }
DI int cond_of_row(int m) { return m < MP ? 0 : 1 + ((m - MP) >> 12); }
DI float rsq(float x) { return 1.0f / sqrtf(x); }
DI void sincos_acc(float y, float& s, float& c) {
    const float n = rintf(y * 0.6366197723675814f);
    float r = fmaf(n, -1.5707962513e+00f, y); r = fmaf(n, -7.5497894159e-08f, r); r = fmaf(n, -5.3903029534e-15f, r);
    const float r2 = r * r;
    float sp = fmaf(r2, 2.7557319e-6f, -1.9841270e-4f); sp = fmaf(sp, r2, 8.3333333e-3f); sp = fmaf(sp, r2, -1.6666667e-1f); sp = fmaf(sp * r2, r, r);
    float cp = fmaf(r2, 2.4801587e-5f, -1.3888889e-3f); cp = fmaf(cp, r2, 4.1666667e-2f); cp = fmaf(cp, r2, -0.5f); cp = fmaf(cp, r2, 1.0f);
    const int q = ((int)n) & 3;
    const float ss = (q & 1) ? cp : sp, cc = (q & 1) ? sp : cp;
    s = (q & 2) ? -ss : ss; c = ((q + 1) & 2) ? -cc : cc;
}
DI float expm1_acc(float x) {
    if (fabsf(x) < 0.35f) { float p = fmaf(x, 1.f / 40320.f, 1.f / 5040.f); p = fmaf(p, x, 1.f / 720.f); p = fmaf(p, x, 1.f / 120.f); p = fmaf(p, x, 1.f / 24.f); p = fmaf(p, x, 1.f / 6.f); p = fmaf(p, x, 0.5f); return fmaf(p * x, x, x); }
    return expf(x) - 1.f;
}
#define MFMA32(a, b, c) __builtin_amdgcn_mfma_f32_32x32x16_bf16((a), (b), (c), 0, 0, 0)
#define MFMA16(a, b, c) __builtin_amdgcn_mfma_f32_16x16x32_bf16((a), (b), (c), 0, 0, 0)
#define LDS_FENCE() asm volatile("s_waitcnt lgkmcnt(0)" ::: "memory")

struct EpiRes {
    static constexpr bool PERM = true, AFTER_DRAIN = false;
    const float* base_p; const float* base_s;
    float* out; const float* gate;
    DI void operator()(const pg8::f32x4 (&acc)[2][2][4][2], const pg8::Unit& u, int wr, int wc, int fr, int fq) const {
        const int row0 = u.pm * 256 + wr * 64 + fr; const int cnd = cond_of_row(u.pm * 256);
        const float* g = gate + cnd * 6144; const int col0 = u.pn * 256 + wc * 32 + 8 * fq;
        f32x4 gv[2][2];
#pragma unroll
        for (int bj = 0; bj < 2; ++bj)
#pragma unroll
            for (int n = 0; n < 2; ++n) gv[bj][n] = *(const f32x4*)(g + col0 + bj * 128 + n * 4);
        const float* bb = (u.pm * 256 < MP) ? base_p + (size_t)row0 * 1024 : base_s + (size_t)(row0 - MP) * 1024;
        float* oo = out + (size_t)row0 * 1024;
#pragma unroll
        for (int ai = 0; ai < 2; ++ai)
#pragma unroll
            for (int m = 0; m < 4; ++m) { const size_t ro = (size_t)(ai * 128 + m * 16) * 1024;
#pragma unroll
                for (int bj = 0; bj < 2; ++bj)
#pragma unroll
                    for (int n = 0; n < 2; ++n) { const int c = col0 + bj * 128 + n * 4; const f32x4 b = *(const f32x4*)(bb + ro + c); *(f32x4*)(oo + ro + c) = b + gv[bj][n] * acc[ai][bj][m][n]; } }
    }
};
struct EpiSwiglu {
    static constexpr bool PERM = true, AFTER_DRAIN = false;
    bf16* O;
    DI void operator()(const pg8::f32x4 (&acc)[2][2][4][2], const pg8::Unit& u, int wr, int wc, int fr, int fq) const {
        const int row0 = u.pm * 256 + wr * 64 + fr; const int hcol0 = u.pn * 128 + wc * 32 + 8 * fq;
#pragma unroll
        for (int ai = 0; ai < 2; ++ai)
#pragma unroll
            for (int m = 0; m < 4; ++m) { float v[8];
#pragma unroll
                for (int n = 0; n < 2; ++n) { const f32x4 g = acc[ai][0][m][n], up = acc[ai][1][m][n];
#pragma unroll
                    for (int e = 0; e < 4; ++e) v[4 * n + e] = g[e] * __builtin_amdgcn_rcpf(1.f + __expf(-g[e])) * up[e]; }
                u32x4 o; o.x = pk2(v[0], v[1]); o.y = pk2(v[2], v[3]); o.z = pk2(v[4], v[5]); o.w = pk2(v[6], v[7]);
                *(u32x4*)(O + (size_t)(row0 + ai * 128 + m * 16) * DFF + hcol0) = o; }
    }
};

DI int rowmap(int mode, int n) { if (mode == 0) return n; if (n < DFF) return 256 * (n >> 7) + (n & 127); n -= DFF; return 256 * (n >> 7) + 128 + (n & 127); }
DI void transpose_item(const float* W, int K, int N, bf16* WT, int row_off, int mode, LAS float* scr, int item, int lane) {
    const int nblk = N / 32, kb = item / nblk, nb = item % nblk, k0 = 64 * kb, n0 = 32 * nb;
#pragma unroll 8
    for (int i = 0; i < 32; ++i) { const int kk = 2 * i + (lane >> 5); scr[kk * 33 + (lane & 31)] = W[(size_t)(k0 + kk) * N + n0 + (lane & 31)]; }
    LDS_FENCE();
    const int c = lane & 7;
#pragma unroll
    for (int j = 0; j < 4; ++j) { const int n = (lane >> 3) + 8 * j; const LAS float* s = scr + (8 * c) * 33 + n;
        u32x4 o; o.x = pk2(s[0 * 33], s[1 * 33]); o.y = pk2(s[2 * 33], s[3 * 33]); o.z = pk2(s[4 * 33], s[5 * 33]); o.w = pk2(s[6 * 33], s[7 * 33]);
        *(u32x4*)(WT + (size_t)(row_off + rowmap(mode, n0 + n)) * K + k0 + 8 * c) = o; }
    LDS_FENCE();
}
DI void p0_convert(const Args& a, LAS unsigned char* lds, int gw, int ngw, int w, int lane) {
    LAS float* scr = (LAS float*)(lds + w * 16384);
    constexpr int I_IN = 16 * 41, I_OUT = 16 * 32, I_F1 = 16 * 176, I_F2 = 44 * 32, I_UQ = 4 * 18, I_UK = 2 * 12, I_GLU = 4 * 8;
    constexpr int PER = I_IN + I_OUT + I_F1 + I_F2 + I_UQ + 2 * I_UK + I_GLU;
    for (int it = gw; it < PER * NLAYER; it += ngw) {
        const int l = it / PER; int r = it % PER;
        if (r < I_IN) { transpose_item(a.in[14] + (size_t)l * 1024 * 1312, 1024, 1312, (bf16*)(a.ws + WS_WIN) + (size_t)l * 1536 * 1024, 0, 0, scr, r, lane); continue; } r -= I_IN;
        if (r < I_OUT) { transpose_item(a.in[32] + (size_t)l * 1024 * 1024, 1024, 1024, (bf16*)(a.ws + WS_WOUT) + (size_t)l * 1024 * 1024, 0, 0, scr, r, lane); continue; } r -= I_OUT;
        if (r < I_F1) { transpose_item(a.in[33] + (size_t)l * 1024 * 5632, 1024, 5632, (bf16*)(a.ws + WS_WF1) + (size_t)l * 5632 * 1024, 0, 1, scr, r, lane); continue; } r -= I_F1;
        if (r < I_F2) { transpose_item(a.in[34] + (size_t)l * 2816 * 1024, 2816, 1024, (bf16*)(a.ws + WS_WF2) + (size_t)l * 1024 * 2816, 0, 0, scr, r, lane); continue; } r -= I_F2;
        if (r < I_UQ) { transpose_item(a.in[19] + (size_t)l * 256 * 576, 256, 576, (bf16*)(a.ws + WS_WUQ) + (size_t)l * 576 * 256, 0, 0, scr, r, lane); continue; } r -= I_UQ;
        if (r < I_UK) { transpose_item(a.in[20] + (size_t)l * 128 * 384, 128, 384, (bf16*)(a.ws + WS_WUKV) + (size_t)l * 768 * 128, 0, 0, scr, r, lane); continue; } r -= I_UK;
        if (r < I_UK) { transpose_item(a.in[21] + (size_t)l * 128 * 384, 128, 384, (bf16*)(a.ws + WS_WUKV) + (size_t)l * 768 * 128, 384, 0, scr, r, lane); continue; } r -= I_UK;
        transpose_item(a.in[30] + (size_t)l * 256 * 256, 256, 256, (bf16*)(a.ws + WS_WGLU) + (size_t)l * 256 * 256, 0, 0, scr, r, lane);
    }
    for (int i = gw * 64 + lane; i < NLAYER * 28672; i += ngw * 64) { const int l = i / 28672, r = i % 28672;
        *(u32x4*)((bf16*)(a.ws + WS_WIN) + ((size_t)l * 1536 + 1312) * 1024 + (size_t)r * 8) = (u32x4){0u, 0u, 0u, 0u}; }
}
DI void ada_partial_item(const Args& a, LAS unsigned char* lds, int it, int tid) {
    const int l = it / 192, r = it % 192, cb = r >> 3, ks = r & 7;
    LAS float* s = (LAS float*)lds;
    LAS float* red = (LAS float*)(lds + 8192);
    const float* c_in = a.in[8]; const float* c_ctx = a.in[9];
    for (int i = tid; i < 9 * 128; i += 512) { const int c = i >> 7, k = i & 127, kk = ks * 128 + k; const float x = c == 0 ? c_ctx[kk] : c_in[(c - 1) * 1024 + kk]; s[i] = x / (1.f + expf(-x)); }
    __syncthreads();
    const int col = cb * 256 + (tid & 255), half = tid >> 8;
    const float* W = a.in[12] + ((size_t)l * 1024 + ks * 128 + half * 64) * 6144 + col;
    float acc[9];
#pragma unroll
    for (int c = 0; c < 9; ++c) acc[c] = 0.f;
#pragma unroll 4
    for (int k = 0; k < 64; ++k) { const float wv = W[(size_t)k * 6144];
#pragma unroll
        for (int c = 0; c < 9; ++c) acc[c] = fmaf(s[c * 128 + half * 64 + k], wv, acc[c]); }
    if (half == 1) {
#pragma unroll
        for (int c = 0; c < 9; ++c) red[c * 256 + (tid & 255)] = acc[c]; }
    __syncthreads();
    if (half == 0) { float* P = (float*)(a.ws + WS_MODP) + ((size_t)(l * 8 + ks) * 9) * 6144;
#pragma unroll
        for (int c = 0; c < 9; ++c) P[(size_t)c * 6144 + col] = acc[c] + red[c * 256 + tid]; }
    __syncthreads();
}

DI void norm_rows(const float* xp, const float* xs, const float* g, const float* mod_l, int sh_off, int sc_off, bf16* H, int gw, int ngw, int lane) {
    for (int m = gw; m < MT; m += ngw) {
        const float* xr = (m < MP) ? xp + (size_t)m * 1024 : xs + (size_t)(m - MP) * 1024;
        f32x4 v[4]; float ss = 0.f;
#pragma unroll
        for (int j = 0; j < 4; ++j) { v[j] = ((const f32x4*)xr)[lane + 64 * j]; ss += (v[j].x * v[j].x + v[j].y * v[j].y) + (v[j].z * v[j].z + v[j].w * v[j].w); }
        const float rstd = rsq(wave_sum(ss) * (1.f / 1024.f) + EPS);
        const float* md = mod_l + cond_of_row(m) * 6144;
        u32x2* o8 = (u32x2*)(H + (size_t)m * 1024);
#pragma unroll
        for (int j = 0; j < 4; ++j) { const int idx = 4 * (lane + 64 * j);
            const f32x4 gg = *(const f32x4*)(g + idx), sc = *(const f32x4*)(md + sc_off + idx), sh = *(const f32x4*)(md + sh_off + idx);
            const f32x4 o = v[j] * rstd * gg * (sc + 1.0f) + sh; u32x2 pk; pk.x = pk2(o.x, o.y); pk.y = pk2(o.z, o.w); o8[lane + 64 * j] = pk; }
    }
}
DI void final_norm_rows(float* X, const float* g, int gw, int ngw, int lane) {
    for (int m = gw; m < MT; m += ngw) {
        f32x4* xr = (f32x4*)(X + (size_t)m * 1024);
        f32x4 v[4]; float ss = 0.f;
#pragma unroll
        for (int j = 0; j < 4; ++j) { v[j] = xr[lane + 64 * j]; ss += (v[j].x * v[j].x + v[j].y * v[j].y) + (v[j].z * v[j].z + v[j].w * v[j].w); }
        const float rstd = rsq(wave_sum(ss) * (1.f / 1024.f) + EPS);
#pragma unroll
        for (int j = 0; j < 4; ++j) { const f32x4 gg = *(const f32x4*)(g + 4 * (lane + 64 * j)); xr[lane + 64 * j] = v[j] * rstd * gg; }
    }
}


template <int NB, int NK, int PA, int KW>
DI void small_gemm(const LAS bf16* A, const bf16* W, int krot, f32x4 (&acc)[NB][2], int n16, int kq) {
    bf16x8 bb[2][NB];
    { const int ks = krot & (NK - 1);
#pragma unroll
      for (int c = 0; c < NB; ++c) bb[0][c] = *(const bf16x8*)(W + (size_t)c * 16 * KW + ks * 32); }
#pragma unroll
    for (int i = 0; i < NK; ++i) { const int cur = i & 1, ks = (i + krot) & (NK - 1);
        if (i + 1 < NK) { const int kn = (i + 1 + krot) & (NK - 1);
#pragma unroll
            for (int c = 0; c < NB; ++c) bb[cur ^ 1][c] = *(const bf16x8*)(W + (size_t)c * 16 * KW + kn * 32); }
        const bf16x8 a0 = *(const LAS bf16x8*)(A + n16 * PA + ks * 32 + 8 * kq), a1 = *(const LAS bf16x8*)(A + (16 + n16) * PA + ks * 32 + 8 * kq);
        __builtin_amdgcn_sched_barrier(0);
#pragma unroll
        for (int c = 0; c < NB; ++c) { acc[c][0] = MFMA16(a0, bb[cur][c], acc[c][0]); acc[c][1] = MFMA16(a1, bb[cur][c], acc[c][1]); }
        __builtin_amdgcn_sched_barrier(0);
    }
}

constexpr int L2_TAB = 0;
constexpr int L2_ACQ = 12288;
constexpr int L2_ACKV = L2_ACQ + 16896;
constexpr int L2_QBS = L2_ACKV + 8704;
constexpr int L2_KBS = L2_QBS + 36864;
constexpr int L2_VTBS = L2_KBS + 36864;
constexpr int L2_VTAS = L2_VTBS + 24576;
static_assert(L2_VTAS + 8192 <= LDS_BYTES, "L2 LDS");
DI size_t vtbase(int seq, int C) { return seq < 16 ? (size_t)seq * C * 256 : (size_t)16 * C * 256 + (size_t)(seq - 16) * C * LKS; }

DI void post_tables(LAS unsigned char* lds, int tid) {
    LAS float* c16 = (LAS float*)(lds + L2_TAB); LAS float* s16 = c16 + 1024; LAS float* c8 = c16 + 2048; LAS float* s8 = c16 + 2560;
    for (int i = tid; i < 1024; i += 512) { const int p = i >> 4, f = i & 15; const float inv = exp2f(-(float)f * (13.287712379549449f / 16.f)); float s, c; sincos_acc((float)p * inv, s, c); c16[i] = c; s16[i] = s; }
    for (int i = tid; i < 512; i += 512) { const int p = i >> 3, f = i & 7; const float inv = exp2f(-(float)f * (13.287712379549449f / 8.f)); float s, c; sincos_acc((float)p * inv, s, c); c8[i] = c; s8[i] = s; }
}

template <int PABL>
DI void post_item(const Args& a, LAS unsigned char* lds, int l, int item, int tid, int lane, int w) {
    const bool is_cache = item >= 1152;
    int m0 = 0, seq, t0, krow0; bool sample;
    if (!is_cache) { m0 = item * 32;
        if (m0 < MP) { seq = m0 >> 8; t0 = m0 & 255; sample = false; krow0 = m0; }
        else { const int r = m0 - MP; seq = 16 + (r >> 12); t0 = r & 4095; sample = true; krow0 = MP + (seq - 16) * LKS + t0; } }
    else { const int j = item - 1152, b = j >> 4; seq = 16 + b; t0 = NSL + (j & 15) * 32; sample = true; krow0 = MP + b * LKS + t0; }
    const int Lk = seq < 16 ? 256 : LKS;
    const LAS float* c16 = (const LAS float*)(lds + L2_TAB); const LAS float* s16 = c16 + 1024; const LAS float* c8 = c16 + 2048; const LAS float* s8 = c16 + 2560;
    LAS bf16* ACQ = (LAS bf16*)(lds + L2_ACQ); LAS bf16* ACKV = (LAS bf16*)(lds + L2_ACKV);
    LAS bf16* QBS = (LAS bf16*)(lds + L2_QBS); LAS bf16* KBS = (LAS bf16*)(lds + L2_KBS);
    LAS bf16* VTBS = (LAS bf16*)(lds + L2_VTBS); LAS bf16* VTAS = (LAS bf16*)(lds + L2_VTAS);
    bf16* QA = (bf16*)(a.ws + WS_QA); bf16* QB = (bf16*)(a.ws + WS_QB); bf16* KA = (bf16*)(a.ws + WS_KA); bf16* KB = (bf16*)(a.ws + WS_KB);
    bf16* VTA = (bf16*)(a.ws + WS_VTA); bf16* VTB = (bf16*)(a.ws + WS_VTB); bf16* UU = (bf16*)(a.ws + WS_UU);
    const bf16* PROJ = (const bf16*)(a.ws + WS_PROJ);
    if (PABL & 1) {} else
    if (!is_cache) {
        const int hd = lane >> 3, sub = lane & 7;
        const float* nw = (hd < 6) ? a.in[15] + l * 64 : a.in[16] + l * 64;
        const f32x4 nw0 = *(const f32x4*)(nw + 4 * sub), nw1 = *(const f32x4*)(nw + 32 + 4 * sub);
        const int e2 = (lane < 16) ? 512 + 8 * lane : (lane < 48) ? 640 + 8 * (lane - 16) : 896 + 8 * (lane - 48);
        const float* n2p = (lane < 48) ? a.in[17] + l * 256 + 8 * ((lane - 16) & 31) : a.in[18] + l * 128 + 8 * (lane - 48);
        const f32x4 n20 = *(const f32x4*)n2p, n21 = *(const f32x4*)(n2p + 4);
        u32x2 qa0[4], qa1[4]; u32x4 ld2[4]; u32x2 kr0[4], kr1[4]; u32x4 ldu[4];
#pragma unroll
        for (int rr = 0; rr < 4; ++rr) { const bf16* pr = PROJ + (size_t)(m0 + 4 * w + rr) * NINP;
            qa0[rr] = *(const u32x2*)(pr + hd * 64 + 4 * sub); qa1[rr] = *(const u32x2*)(pr + hd * 64 + 32 + 4 * sub);
            ld2[rr] = *(const u32x4*)(pr + e2);
            if (lane < 4) { kr0[rr] = *(const u32x2*)(pr + 1024 + 4 * lane); kr1[rr] = *(const u32x2*)(pr + 1040 + 4 * lane); }
            else if (lane < 36) ldu[rr] = *(const u32x4*)(pr + 1056 + 8 * (lane - 4)); }
#pragma unroll
        for (int rr = 0; rr < 4; ++rr) {
            const int r = 4 * w + rr, m = m0 + r, t = t0 + r, trow = t >> 6, tcol = t & 63;
            const size_t orow = (size_t)((seq * 4 + l) * 256 + t);
            { float x0[4] = {bflo(qa0[rr].x), bfhi(qa0[rr].x), bflo(qa0[rr].y), bfhi(qa0[rr].y)}, x1[4] = {bflo(qa1[rr].x), bfhi(qa1[rr].x), bflo(qa1[rr].y), bfhi(qa1[rr].y)};
              float ss = (x0[0] * x0[0] + x0[1] * x0[1]) + (x0[2] * x0[2] + x0[3] * x0[3]) + (x1[0] * x1[0] + x1[1] * x1[1]) + (x1[2] * x1[2] + x1[3] * x1[3]);
              ss += __shfl_xor(ss, 1); ss += __shfl_xor(ss, 2); ss += __shfl_xor(ss, 4);
              const float rs = rsq(ss * (1.f / 64.f) + EPS);
#pragma unroll
              for (int e = 0; e < 4; ++e) { x0[e] *= rs * nw0[e]; x1[e] *= rs * nw1[e]; }
              if (hd >= 6 && !sample) { float* ok = a.out + O_K + (orow * 2 + (hd - 6)) * 64; *(f32x4*)(ok + 4 * sub) = (f32x4){x0[0], x0[1], x0[2], x0[3]}; *(f32x4*)(ok + 32 + 4 * sub) = (f32x4){x1[0], x1[1], x1[2], x1[3]}; }
              if (sample) { const int p16 = (sub < 4) ? trow : tcol; const f32x4 cs = *(const LAS f32x4*)(c16 + p16 * 16 + 4 * (sub & 3)), sn = *(const LAS f32x4*)(s16 + p16 * 16 + 4 * (sub & 3));
#pragma unroll
                  for (int e = 0; e < 4; ++e) { const float a1 = x0[e], a2 = x1[e]; x0[e] = a1 * cs[e] - a2 * sn[e]; x1[e] = a1 * sn[e] + a2 * cs[e]; } }
              const float sc = (hd < 6) ? QSC_A : 1.f;
              u32x2 o0, o1; o0.x = pk2(x0[0] * sc, x0[1] * sc); o0.y = pk2(x0[2] * sc, x0[3] * sc); o1.x = pk2(x1[0] * sc, x1[1] * sc); o1.y = pk2(x1[2] * sc, x1[3] * sc);
              bf16* dst = (hd < 6) ? QA + (size_t)m * 384 + hd * 64 : KA + (size_t)(krow0 + r) * 128 + (hd - 6) * 64;
              *(u32x2*)(dst + 4 * sub) = o0; *(u32x2*)(dst + 32 + 4 * sub) = o1; }
            { float x[8] = {bflo(ld2[rr].x), bfhi(ld2[rr].x), bflo(ld2[rr].y), bfhi(ld2[rr].y), bflo(ld2[rr].z), bfhi(ld2[rr].z), bflo(ld2[rr].w), bfhi(ld2[rr].w)};
              float ss = (x[0] * x[0] + x[1] * x[1]) + (x[2] * x[2] + x[3] * x[3]) + (x[4] * x[4] + x[5] * x[5]) + (x[6] * x[6] + x[7] * x[7]);
              ss += __shfl_xor(ss, 1); ss += __shfl_xor(ss, 2); ss += __shfl_xor(ss, 4); ss += __shfl_xor(ss, 8);
              const float scq = __int_as_float(__builtin_amdgcn_readlane(__float_as_int(ss), 16)) + __int_as_float(__builtin_amdgcn_readlane(__float_as_int(ss), 32));
              const float skv = __int_as_float(__builtin_amdgcn_readlane(__float_as_int(ss), 48));
              if (lane < 16) {
                  if (!sample) { float* ov = a.out + O_V + orow * 128 + 8 * lane; *(f32x4*)ov = (f32x4){x[0], x[1], x[2], x[3]}; *(f32x4*)(ov + 4) = (f32x4){x[4], x[5], x[6], x[7]}; }
#pragma unroll
                  for (int e = 0; e < 8; ++e) VTAS[(8 * lane + e) * 32 + swap23(r)] = f2bf(x[e]);
              } else if (lane < 48) {
                  const float rs = rsq(scq * (1.f / 256.f) + EPS);
                  u32x4 o; o.x = pk2(x[0] * rs * n20.x, x[1] * rs * n20.y); o.y = pk2(x[2] * rs * n20.z, x[3] * rs * n20.w); o.z = pk2(x[4] * rs * n21.x, x[5] * rs * n21.y); o.w = pk2(x[6] * rs * n21.z, x[7] * rs * n21.w);
                  *(LAS u32x4*)(ACQ + r * 264 + 8 * (lane - 16)) = o;
              } else {
                  const float rs = rsq(skv * (1.f / 128.f) + EPS);
                  const float y0 = x[0] * rs * n20.x, y1 = x[1] * rs * n20.y, y2 = x[2] * rs * n20.z, y3 = x[3] * rs * n20.w, y4 = x[4] * rs * n21.x, y5 = x[5] * rs * n21.y, y6 = x[6] * rs * n21.z, y7 = x[7] * rs * n21.w;
                  if (!sample) { float* oc = a.out + O_CKV + orow * 128 + 8 * (lane - 48); *(f32x4*)oc = (f32x4){y0, y1, y2, y3}; *(f32x4*)(oc + 4) = (f32x4){y4, y5, y6, y7}; }
                  u32x4 o; o.x = pk2(y0, y1); o.y = pk2(y2, y3); o.z = pk2(y4, y5); o.w = pk2(y6, y7);
                  *(LAS u32x4*)(ACKV + r * 136 + 8 * (lane - 48)) = o;
              } }
            if (lane < 4) {
                float x0[4] = {bflo(kr0[rr].x), bfhi(kr0[rr].x), bflo(kr0[rr].y), bfhi(kr0[rr].y)}, x1[4] = {bflo(kr1[rr].x), bfhi(kr1[rr].x), bflo(kr1[rr].y), bfhi(kr1[rr].y)};
                if (!sample) { float* ok = a.out + O_KR + orow * 32; *(f32x4*)(ok + 4 * lane) = (f32x4){x0[0], x0[1], x0[2], x0[3]}; *(f32x4*)(ok + 16 + 4 * lane) = (f32x4){x1[0], x1[1], x1[2], x1[3]}; }
                else { const int p8 = (lane < 2) ? trow : tcol; const f32x4 cs = *(const LAS f32x4*)(c8 + p8 * 8 + 4 * (lane & 1)), sn = *(const LAS f32x4*)(s8 + p8 * 8 + 4 * (lane & 1));
#pragma unroll
                    for (int e = 0; e < 4; ++e) { const float a1 = x0[e], a2 = x1[e]; x0[e] = a1 * cs[e] - a2 * sn[e]; x1[e] = a1 * sn[e] + a2 * cs[e]; } }
                u32x2 o0, o1; o0.x = pk2(x0[0], x0[1]); o0.y = pk2(x0[2], x0[3]); o1.x = pk2(x1[0], x1[1]); o1.y = pk2(x1[2], x1[3]);
#pragma unroll
                for (int h = 0; h < 6; ++h) { *(LAS u32x2*)(KBS + r * 576 + h * 96 + 64 + 4 * lane) = o0; *(LAS u32x2*)(KBS + r * 576 + h * 96 + 80 + 4 * lane) = o1; }
            } else if (lane < 36) *(u32x4*)(UU + (size_t)m * 256 + 8 * (lane - 4)) = ldu[rr];
        }
    } else {
        const int b = seq - 16;
#pragma unroll 1
        for (int rr = 0; rr < 4; ++rr) {
            const int r = 4 * w + rr, p = (t0 - NSL) + r;
            const size_t cb = (size_t)(b * 4 + l) * 512 + p;
            const float* ck = a.in[2] + cb * 128; const float* cv = a.in[3] + cb * 128; const float* cc = a.in[4] + cb * 128; const float* ckr = a.in[5] + cb * 32;
            KA[(size_t)(krow0 + r) * 128 + lane] = f2bf(ck[lane]); KA[(size_t)(krow0 + r) * 128 + 64 + lane] = f2bf(ck[64 + lane]);
            VTAS[lane * 32 + swap23(r)] = f2bf(cv[lane]); VTAS[(64 + lane) * 32 + swap23(r)] = f2bf(cv[64 + lane]);
            { const f32x2 v = *(const f32x2*)(cc + lane * 2); *(LAS unsigned*)(ACKV + r * 136 + lane * 2) = pk2(v.x, v.y); }
            if (lane < 32) { const unsigned short bb = f2bf(ckr[lane]);
#pragma unroll
                for (int h = 0; h < 6; ++h) KBS[r * 576 + h * 96 + 64 + lane] = bb; }
        }
    }
    __syncthreads();
    const int n16 = lane & 15, kq = lane >> 4;
    if (!(PABL & 2)) {
    if (!is_cache && w < 6) {
        const bf16* W = (const bf16*)(a.ws + WS_WUQ) + (size_t)l * 576 * 256 + (size_t)(w * 96 + n16) * 256 + 8 * kq;
        f32x4 acc[6][2];
#pragma unroll
        for (int c = 0; c < 6; ++c) { acc[c][0] = (f32x4){0.f, 0.f, 0.f, 0.f}; acc[c][1] = (f32x4){0.f, 0.f, 0.f, 0.f}; }
        small_gemm<6, 8, 264, 256>(ACQ, W, item * 3 + w, acc, n16, kq);
#pragma unroll
        for (int rb = 0; rb < 2; ++rb)
#pragma unroll
            for (int i = 0; i < 4; ++i) { const int row = 16 * rb + 4 * kq + i;
                if (sample) { const int t = t0 + row, p8 = (n16 < 8) ? (t >> 6) : (t & 63); const float c = c8[p8 * 8 + (n16 & 7)], s = s8[p8 * 8 + (n16 & 7)];
                    const float x1 = acc[4][rb][i], x2 = acc[5][rb][i]; acc[4][rb][i] = x1 * c - x2 * s; acc[5][rb][i] = x1 * s + x2 * c; }
#pragma unroll
                for (int c = 0; c < 6; ++c) QBS[row * 576 + w * 96 + c * 16 + n16] = f2bf(acc[c][rb][i] * QSC_B); }
    }
    {
        const bf16* W = (const bf16*)(a.ws + WS_WUKV) + (size_t)l * 768 * 128 + (size_t)(w * 96 + n16) * 128 + 8 * kq;
        f32x4 acc[6][2];
#pragma unroll
        for (int c = 0; c < 6; ++c) { acc[c][0] = (f32x4){0.f, 0.f, 0.f, 0.f}; acc[c][1] = (f32x4){0.f, 0.f, 0.f, 0.f}; }
        small_gemm<6, 4, 136, 128>(ACKV, W, item * 3 + w, acc, n16, kq);
#pragma unroll
        for (int c = 0; c < 6; ++c) { const int cb = w * 6 + c;
#pragma unroll
            for (int rb = 0; rb < 2; ++rb)
#pragma unroll
                for (int i = 0; i < 4; ++i) { const int row = 16 * rb + 4 * kq + i; const unsigned short v = f2bf(acc[c][rb][i]);
                    if (w < 4) KBS[row * 576 + (cb >> 2) * 96 + (cb & 3) * 16 + n16] = v;
                    else { const int cb2 = cb - 24; VTBS[((cb2 >> 2) * 64 + (cb2 & 3) * 16 + n16) * 32 + swap23(row)] = v; } } }
    }
    }
    __syncthreads();
    if (!(PABL & 4)) {
    if (!is_cache) for (int i = tid; i < 2304; i += 512) *(u32x4*)(QB + (size_t)m0 * 576 + (size_t)i * 8) = *(const LAS u32x4*)(QBS + i * 8);
    for (int i = tid; i < 2304; i += 512) *(u32x4*)(KB + (size_t)krow0 * 576 + (size_t)i * 8) = *(const LAS u32x4*)(KBS + i * 8);
    { bf16* dst = VTB + vtbase(seq, 384) + t0;
      for (int i = tid; i < 1536; i += 512) { const int d = i >> 2, ch = i & 3; *(u32x4*)(dst + (size_t)d * Lk + ch * 8) = *(const LAS u32x4*)(VTBS + d * 32 + ch * 8); } }
    { bf16* dst = VTA + vtbase(seq, 128) + t0; const int d = tid >> 2, ch = tid & 3; *(u32x4*)(dst + (size_t)d * Lk + ch * 8) = *(const LAS u32x4*)(VTAS + d * 32 + ch * 8); }
    }
    __syncthreads();
}

DI float max3f(float a, float b, float c) { float r; asm("v_max3_f32 %0, %1, %2, %3" : "=v"(r) : "v"(a), "v"(b), "v"(c)); return r; }
#define SBAR() __builtin_amdgcn_sched_barrier(0)
template <int DQK, bool HN, int ABL>
DI void att_step(f32x16& C0, f32x16& C1, f32x16& N0, f32x16& N1, f32x16& o0, f32x16& o1, f32x16& negm, float& mref, float& lsum,
                 const bf16x8 (&qf)[DQK / 16], const LAS unsigned char* kb, const LAS unsigned char* vb) {
    constexpr int ND = DQK / 16, NQ = 2 * ND, KP = DQK * 2 + 16, VP = 144, NI = NQ > 8 ? NQ : 8;
    constexpr int AH = 4;
    bf16x8 kf[NQ];
    if (HN) {
#pragma unroll
        for (int i = 0; i < AH; ++i) kf[i] = *(const LAS bf16x8*)(kb + (i & 1) * 32 * KP + (i >> 1) * 32);
    }
    SBAR();
    u32x4 pw[4];
#pragma unroll
    for (int i = 0; i < NI; ++i) {
        if (HN && i < NQ) { if (i & 1) N1 = MFMA32(kf[i], qf[i >> 1], (i < 2) ? negm : N1); else N0 = MFMA32(kf[i], qf[i >> 1], (i < 2) ? negm : N0); }
        if (HN && i + AH < NQ) kf[i + AH] = *(const LAS bf16x8*)(kb + ((i + AH) & 1) * 32 * KP + ((i + AH) >> 1) * 32);
        if (i < 8) {
#pragma unroll
            for (int e = 0; e < 4; ++e) { const int idx = 4 * (i & 3) + e; if (ABL & 1) { if (i < 4) C0[idx] = fmaf(C0[idx], 0.001f, 1.f); else C1[idx] = fmaf(C1[idx], 0.001f, 1.f); } else { if (i < 4) C0[idx] = __builtin_amdgcn_exp2f(C0[idx]); else C1[idx] = __builtin_amdgcn_exp2f(C1[idx]); } }
            if (i & 1) { const int k = i >> 1, b8 = 8 * (k & 1);
                if (k < 2) { pw[k].x = pk2(C0[b8], C0[b8 + 1]); pw[k].y = pk2(C0[b8 + 2], C0[b8 + 3]); pw[k].z = pk2(C0[b8 + 4], C0[b8 + 5]); pw[k].w = pk2(C0[b8 + 6], C0[b8 + 7]); }
                else { pw[k].x = pk2(C1[b8], C1[b8 + 1]); pw[k].y = pk2(C1[b8 + 2], C1[b8 + 3]); pw[k].z = pk2(C1[b8 + 4], C1[b8 + 5]); pw[k].w = pk2(C1[b8 + 6], C1[b8 + 7]); } }
        }
        SBAR();
    }
    bf16x8 vf[8];
#pragma unroll
    for (int i = 0; i < AH; ++i) vf[i] = *(const LAS bf16x8*)(vb + (i & 1) * 32 * VP + (i >> 1) * 32);
    SBAR();
    float ps = 0.f, mx = -3.0e38f;
#pragma unroll
    for (int i = 0; i < 8; ++i) {
        if (i & 1) o1 = MFMA32(vf[i], __builtin_bit_cast(bf16x8, pw[i >> 1]), o1); else o0 = MFMA32(vf[i], __builtin_bit_cast(bf16x8, pw[i >> 1]), o0);
        if (i + AH < 8) vf[i + AH] = *(const LAS bf16x8*)(vb + ((i + AH) & 1) * 32 * VP + ((i + AH) >> 1) * 32);
        if (HN && i == 0) asm volatile("s_nop 11" : "+v"(N0), "+v"(N1));
#pragma unroll
        for (int e = 0; e < 4; ++e) { const int idx = 4 * (i & 3) + e; ps += (i < 4) ? C0[idx] : C1[idx]; }
        if (HN && !(ABL & 8)) { mx = max3f(mx, N0[2 * i], N1[2 * i]); mx = max3f(mx, N0[2 * i + 1], N1[2 * i + 1]); }
        SBAR();
    }
    lsum += ps;
    if (HN && !(ABL & 8)) {
        { auto rr = __builtin_amdgcn_permlane32_swap(__float_as_uint(mx), __float_as_uint(mx), false, false); mx = fmaxf(__uint_as_float(rr[0]), __uint_as_float(rr[1])); }
        if (__any(mx > 8.f)) { const float dl = fmaxf(mx, 0.f); mref += dl; const float f = __builtin_amdgcn_exp2f(-dl);
#pragma unroll
            for (int i = 0; i < 16; ++i) { N0[i] -= dl; N1[i] -= dl; negm[i] = -mref; o0[i] *= f; o1[i] *= f; }
            lsum *= f; }
    }
}

template <int DQK, int ABL>
DI void attn_unit(LAS unsigned char* lds, const bf16* Q, int qpitch, const bf16* K, int kpitch, const bf16* VT, int Lk, bf16* O, int tid_in) {
    constexpr int ND = DQK / 16, NQ = 2 * ND, KP = DQK * 2 + 16, VP = 144, NCH = DQK / 8, KBUF = 64 * KP, VBUF = 64 * VP;
    LAS unsigned char* Kl = lds; LAS unsigned char* Vl = lds + 2 * KBUF;
    int tid = tid_in; asm volatile("" : "+v"(tid));
    const int lane = tid & 63, w = __builtin_amdgcn_readfirstlane(tid >> 6);
    const int r = lane & 31, hh = lane >> 5;
    const int kr0 = tid / NCH, kc0 = tid % NCH, kr1 = (tid + 512) / NCH, kc1 = (tid + 512) % NCH;
    const bool k2 = (DQK == 96) && (tid < 256);
    const int vd = tid >> 3, vc = tid & 7;
    u32x4 kreg0, kreg1 = (u32x4){0u, 0u, 0u, 0u}, vreg;
#define ATT_LOADK(tile) do { if (ABL & 2) break; kreg0 = *(const u32x4*)(K + (size_t)((tile) * 64 + kr0) * kpitch + kc0 * 8); \
        if (k2) kreg1 = *(const u32x4*)(K + (size_t)((tile) * 64 + kr1) * kpitch + kc1 * 8); } while (0)
#define ATT_LOADV(tile) do { if (ABL & 2) break; vreg = *(const u32x4*)(VT + (size_t)vd * Lk + (tile) * 64 + vc * 8); } while (0)
#define ATT_STOREK(buf) do { if (ABL & 2) break; *(LAS u32x4*)(Kl + (buf) * KBUF + kr0 * KP + kc0 * 16) = kreg0; \
        if (k2) *(LAS u32x4*)(Kl + (buf) * KBUF + kr1 * KP + kc1 * 16) = kreg1; } while (0)
#define ATT_STOREV(buf) do { if (ABL & 2) break; *(LAS u32x4*)(Vl + (buf) * VBUF + vd * VP + vc * 16) = vreg; } while (0)
    bf16x8 qf[ND];
#pragma unroll
    for (int d0 = 0; d0 < ND; ++d0) qf[d0] = *(const bf16x8*)(Q + (size_t)(w * 32 + r) * qpitch + d0 * 16 + hh * 8);
    const int NT = Lk >> 6;
    ATT_LOADK(0); ATT_STOREK(0); ATT_LOADV(0); ATT_STOREV(0); ATT_LOADK(1); ATT_STOREK(1);
    __syncthreads();
    const LAS unsigned char* kbase = Kl + r * KP + hh * 16;
    const LAS unsigned char* vbase = Vl + r * VP + hh * 16;
    f32x16 A0, A1, B0, B1, o0, o1, negm;
#pragma unroll
    for (int i = 0; i < 16; ++i) { A0[i] = 0.f; A1[i] = 0.f; B0[i] = 0.f; B1[i] = 0.f; o0[i] = 0.f; o1[i] = 0.f; }
    {
        bf16x8 kf[NQ];
#pragma unroll
        for (int i = 0; i < NQ; ++i) kf[i] = *(const LAS bf16x8*)(kbase + (i & 1) * 32 * KP + (i >> 1) * 32);
#pragma unroll
        for (int i = 0; i < NQ; ++i) { if (i & 1) A1 = MFMA32(kf[i], qf[i >> 1], A1); else A0 = MFMA32(kf[i], qf[i >> 1], A0); }
    }
    float mref = fmaxf(A0[0], A1[0]);
#pragma unroll
    for (int i = 1; i < 16; ++i) mref = fmaxf(mref, fmaxf(A0[i], A1[i]));
    mref = fmaxf(mref, __shfl_xor(mref, 32));
#pragma unroll
    for (int i = 0; i < 16; ++i) { A0[i] -= mref; A1[i] -= mref; negm[i] = -mref; }
    float lsum = 0.f;
#pragma unroll 1
    for (int t = 0; t + 2 < NT; t += 2) {
        ATT_LOADK(t + 2); ATT_LOADV(t + 1);
        att_step<DQK, true, ABL>(A0, A1, B0, B1, o0, o1, negm, mref, lsum, qf, kbase + KBUF, vbase);
        ATT_STOREK(0); ATT_STOREV(1); if (!(ABL & 4)) __syncthreads();
        ATT_LOADK(t + 3); ATT_LOADV(t + 2);
        att_step<DQK, true, ABL>(B0, B1, A0, A1, o0, o1, negm, mref, lsum, qf, kbase, vbase + VBUF);
        ATT_STOREK(1); ATT_STOREV(0); if (!(ABL & 4)) __syncthreads();
    }
    ATT_LOADV(NT - 1);
    att_step<DQK, true, ABL>(A0, A1, B0, B1, o0, o1, negm, mref, lsum, qf, kbase + KBUF, vbase);
    ATT_STOREV(1); __syncthreads();
    att_step<DQK, false, ABL>(B0, B1, A0, A1, o0, o1, negm, mref, lsum, qf, kbase, vbase + VBUF);
    __syncthreads();
#undef ATT_LOADK
#undef ATT_LOADV
#undef ATT_STOREK
#undef ATT_STOREV
    lsum += __shfl_xor(lsum, 32);
    const float inv = 1.f / lsum;
    bf16* op = O + (size_t)(w * 32 + r) * 1024;
    if (!(ABL & 16) || lsum == 1.2345e-30f)
#pragma unroll
    for (int g4 = 0; g4 < 4; ++g4) { const int d = 8 * g4 + 4 * hh; u32x2 x0, x1;
        x0.x = pk2(o0[4 * g4] * inv, o0[4 * g4 + 1] * inv); x0.y = pk2(o0[4 * g4 + 2] * inv, o0[4 * g4 + 3] * inv);
        x1.x = pk2(o1[4 * g4] * inv, o1[4 * g4 + 1] * inv); x1.y = pk2(o1[4 * g4 + 2] * inv, o1[4 * g4 + 3] * inv);
        *(u32x2*)(op + d) = x0; *(u32x2*)(op + 32 + d) = x1; }
}

template <bool WY>
DI void s5_run(LAS float* wl, const bf16* U, float* Y, int L, int dir, int c_lo, int c_hi, const bf16x8 (&bfr)[4], const bf16x8 (&cfr)[4], float ar, float ai, float& sre, float& sim, int lane) {
    const int pl = lane & 31, hh = lane >> 5, n16 = lane & 15, kq = lane >> 4;
    f32x16 zero16;
#pragma unroll
    for (int i = 0; i < 16; ++i) zero16[i] = 0.f;
    bf16x8 uf_n0, uf_n1;
    { const int t0 = dir ? (L - 1 - c_lo - pl) : (c_lo + pl); uf_n0 = *(const bf16x8*)(U + (size_t)t0 * 256 + 8 * hh);
      const int t1 = dir ? (L - 1 - c_lo - 32 - pl) : (c_lo + 32 + pl); uf_n1 = *(const bf16x8*)(U + (size_t)t1 * 256 + 8 * hh); }
#pragma unroll 1
    for (int c0 = c_lo; c0 < c_hi; c0 += 32) {
        const bf16x8 uf = uf_n0; uf_n0 = uf_n1;
        if (c0 + 64 < c_hi) { const int t2 = dir ? (L - 1 - c0 - 64 - pl) : (c0 + 64 + pl); uf_n1 = *(const bf16x8*)(U + (size_t)t2 * 256 + 8 * hh); }
#pragma unroll
        for (int blk = 0; blk < 4; ++blk) { const f32x16 d = MFMA32(uf, bfr[blk], zero16);
#pragma unroll
            for (int i = 0; i < 16; ++i) wl[crow(i, hh) * 132 + blk * 32 + pl] = d[i]; }
        LDS_FENCE();
        {
            float br_[32], bi_[32];
#pragma unroll
            for (int tau = 0; tau < 32; ++tau) { br_[tau] = wl[tau * 132 + lane]; bi_[tau] = wl[tau * 132 + 64 + lane]; }
#pragma unroll
            for (int tau = 0; tau < 32; ++tau) { const float n_r = fmaf(ar, sre, fmaf(-ai, sim, br_[tau])), n_i = fmaf(ar, sim, fmaf(ai, sre, bi_[tau])); sre = n_r; sim = n_i; br_[tau] = n_r; bi_[tau] = n_i; }
            if (WY) {
#pragma unroll
                for (int tau = 0; tau < 32; ++tau) { wl[tau * 132 + lane] = br_[tau]; wl[tau * 132 + 64 + lane] = bi_[tau]; } }
        }
        LDS_FENCE();
        if (WY) {
#pragma unroll
            for (int rb = 0; rb < 2; ++rb) { f32x4 acc = (f32x4){0.f, 0.f, 0.f, 0.f};
#pragma unroll
                for (int ks = 0; ks < 4; ++ks) { const LAS float* sp = wl + (rb * 16 + n16) * 132 + 32 * ks + 8 * kq; const f32x4 s0 = *(const LAS f32x4*)sp, s1 = *(const LAS f32x4*)(sp + 4);
                    u32x4 pw; pw.x = pk2(s0.x, s0.y); pw.y = pk2(s0.z, s0.w); pw.z = pk2(s1.x, s1.y); pw.w = pk2(s1.z, s1.w);
                    acc = MFMA16(__builtin_bit_cast(bf16x8, pw), cfr[ks], acc); }
#pragma unroll
                for (int i = 0; i < 4; ++i) { const int tau = rb * 16 + 4 * kq + i; const int tt = dir ? (L - 1 - c0 - tau) : (c0 + tau); Y[(size_t)tt * 256 + n16] = acc[i]; } }
            LDS_FENCE();
        }
    }
}
template <bool SPLIT>
DI void s5_task(const Args& a, LAS float* wl, LAS float* xl, int l, int seq, int g, int dir, int lane, int w) {
    const int L = seq < 16 ? 256 : 4096; const int mbase = seq < 16 ? seq * 256 : MP + (seq - 16) * 4096;
    const int pidx = (l * 2 + dir) * 16 + g;
    const float lre = a.in[22][pidx * 64 + lane], lim = a.in[23][pidx * 64 + lane], dt = expf(a.in[24][pidx]);
    const float x = lre * dt, y = lim * dt, ex = expf(x); float sy, cy; sincos_acc(y, sy, cy);
    const float ar = ex * cy, ai = ex * sy;
    float shh, chh; sincos_acc(0.5f * y, shh, chh);
    const float nr = expm1_acc(x) * cy - 2.f * shh * shh, ni = ex * sy, den = lre * lre + lim * lim;
    const float cre = (nr * lre + ni * lim) / den, cim = (ni * lre - nr * lim) / den;
    const int pl = lane & 31, hh = lane >> 5, n16 = lane & 15, kq = lane >> 4;
    bf16x8 bfr[4];
#pragma unroll
    for (int blk = 0; blk < 4; ++blk) { const int ps = (blk & 1) * 32 + pl; const float cr = __shfl(cre, ps), ci = __shfl(cim, ps);
        const float* br = a.in[25] + ((size_t)pidx * 64 + ps) * 16 + 8 * hh; const float* bi = a.in[26] + ((size_t)pidx * 64 + ps) * 16 + 8 * hh;
        const f32x4 r0 = *(const f32x4*)br, r1 = *(const f32x4*)(br + 4), i0 = *(const f32x4*)bi, i1 = *(const f32x4*)(bi + 4);
        f32x4 v0, v1; if (blk < 2) { v0 = r0 * cr - i0 * ci; v1 = r1 * cr - i1 * ci; } else { v0 = i0 * cr + r0 * ci; v1 = i1 * cr + r1 * ci; }
        u32x4 pw; pw.x = pk2(v0.x, v0.y); pw.y = pk2(v0.z, v0.w); pw.z = pk2(v1.x, v1.y); pw.w = pk2(v1.z, v1.w); bfr[blk] = __builtin_bit_cast(bf16x8, pw); }
    bf16x8 cfr[4];
#pragma unroll
    for (int ks = 0; ks < 4; ++ks) { const int k0 = 32 * ks + 8 * kq; const float* src = (k0 < 64) ? a.in[27] + ((size_t)pidx * 16 + n16) * 64 + k0 : a.in[28] + ((size_t)pidx * 16 + n16) * 64 + (k0 - 64);
        const float sg = (k0 < 64) ? 1.f : -1.f; const f32x4 c0 = *(const f32x4*)src * sg, c1 = *(const f32x4*)(src + 4) * sg;
        u32x4 pw; pw.x = pk2(c0.x, c0.y); pw.y = pk2(c0.z, c0.w); pw.z = pk2(c1.x, c1.y); pw.w = pk2(c1.z, c1.w); cfr[ks] = __builtin_bit_cast(bf16x8, pw); }
    float sre = 0.f, sim = 0.f;
    if (seq >= 16) { const size_t si = ((size_t)(((seq - 16) * 4 + l) * 2 + dir) * 16 + g) * 64 + lane; sre = a.in[6][si]; sim = a.in[7][si]; }
    const bf16* U = (const bf16*)(a.ws + WS_UU) + (size_t)mbase * 256 + g * 16;
    float* Y = (float*)(a.ws + WS_H) + (size_t)dir * MT * 256 + (size_t)mbase * 256 + g * 16;
    if (!SPLIT) {
        s5_run<true>(wl, U, Y, L, dir, 0, L, bfr, cfr, ar, ai, sre, sim, lane);
        if (seq < 16) { const size_t so = ((size_t)((seq * 4 + l) * 2 + dir) * 16 + g) * 64 + lane; a.out[O_SRE + so] = sre; a.out[O_SIM + so] = sim; }
    } else {
        const int c_lo = w * 512, c_hi = c_lo + 512;
        float er = 0.f, ei = 0.f;
        if (w < 7) s5_run<false>(wl, U, Y, L, dir, c_lo, c_hi, bfr, cfr, ar, ai, er, ei, lane);
        xl[w * 128 + lane] = er; xl[w * 128 + 64 + lane] = ei;
        __syncthreads();
        float pr = ar, pi = ai;
#pragma unroll
        for (int q = 0; q < 9; ++q) { const float t_r = pr * pr - pi * pi, t_i = 2.f * pr * pi; pr = t_r; pi = t_i; }
        for (int j = 0; j < w; ++j) { const float e_r = xl[j * 128 + lane], e_i = xl[j * 128 + 64 + lane]; const float n_r = fmaf(pr, sre, fmaf(-pi, sim, e_r)), n_i = fmaf(pr, sim, fmaf(pi, sre, e_i)); sre = n_r; sim = n_i; }
        s5_run<true>(wl, U, Y, L, dir, c_lo, c_hi, bfr, cfr, ar, ai, sre, sim, lane);
        __syncthreads();
    }
}

DI void glu_item(const Args& a, LAS unsigned char* lds, int l, int item, int tid, int lane, int w) {
    const int m0 = item * 32;
    LAS bf16* YG = (LAS bf16*)lds;
    LAS float* YF32 = (LAS float*)(lds + 16896);
    const bf16* UU = (const bf16*)(a.ws + WS_UU); const float* YF = (const float*)(a.ws + WS_H); const float* YB = YF + (size_t)MT * 256;
    bf16* MIX = (bf16*)(a.ws + WS_PROJ);
    const int row = tid >> 4, c0 = (tid & 15) * 16; const size_t gro = (size_t)(m0 + row) * 256 + c0;
#pragma unroll
    for (int q = 0; q < 4; ++q) { const u32x2 ur = *(const u32x2*)(UU + gro + q * 4); const f32x4 yf = *(const f32x4*)(YF + gro + q * 4), yb = *(const f32x4*)(YB + gro + q * 4), dd = *(const f32x4*)(a.in[29] + l * 256 + c0 + q * 4);
        f32x4 y; y.x = dd.x * bflo(ur.x) + yf.x + yb.x; y.y = dd.y * bfhi(ur.x) + yf.y + yb.y; y.z = dd.z * bflo(ur.y) + yf.z + yb.z; y.w = dd.w * bfhi(ur.y) + yf.w + yb.w;
#pragma unroll
        for (int e = 0; e < 4; ++e) { const float v = y[e]; const float z = 0.7978845608028654f * (v + 0.044715f * v * v * v); const float th = 1.f - 2.f * __builtin_amdgcn_rcpf(1.f + __expf(2.f * z)); y[e] = 0.5f * v * (1.f + th); }
        *(LAS f32x4*)(YF32 + row * 260 + c0 + q * 4) = y; u32x2 o; o.x = pk2(y.x, y.y); o.y = pk2(y.z, y.w); *(LAS u32x2*)(YG + row * 264 + c0 + q * 4) = o; }
    __syncthreads();
    const int n16 = lane & 15, kq = lane >> 4;
    { const bf16* W = (const bf16*)(a.ws + WS_WGLU) + (size_t)l * 256 * 256 + (size_t)(w * 32 + n16) * 256 + 8 * kq;
      f32x4 acc[2][2];
#pragma unroll
      for (int c = 0; c < 2; ++c) { acc[c][0] = (f32x4){0.f, 0.f, 0.f, 0.f}; acc[c][1] = (f32x4){0.f, 0.f, 0.f, 0.f}; }
      small_gemm<2, 8, 264, 256>(YG, W, item + w, acc, n16, kq);
#pragma unroll
      for (int c = 0; c < 2; ++c) { const int col = w * 32 + c * 16 + n16; const float bg = a.in[31][l * 256 + col];
#pragma unroll
          for (int rb = 0; rb < 2; ++rb)
#pragma unroll
              for (int i = 0; i < 4; ++i) { const int rw = 16 * rb + 4 * kq + i; const float z = acc[c][rb][i] + bg; const float yv = YF32[rw * 260 + col]; YF32[rw * 260 + col] = yv * __builtin_amdgcn_rcpf(1.f + __expf(-z)); } } }
    __syncthreads();
    { u32x4 o0, o1; const LAS float* sp = YF32 + row * 260 + c0; const f32x4 a0 = *(const LAS f32x4*)sp, a1 = *(const LAS f32x4*)(sp + 4), a2 = *(const LAS f32x4*)(sp + 8), a3 = *(const LAS f32x4*)(sp + 12);
      o0.x = pk2(a0.x, a0.y); o0.y = pk2(a0.z, a0.w); o0.z = pk2(a1.x, a1.y); o0.w = pk2(a1.z, a1.w); o1.x = pk2(a2.x, a2.y); o1.y = pk2(a2.z, a2.w); o1.z = pk2(a3.x, a3.y); o1.w = pk2(a3.z, a3.w);
      bf16* dst = MIX + (size_t)(m0 + row) * 1024 + 768 + c0; *(u32x4*)dst = o0; *(u32x4*)(dst + 8) = o1; }
    __syncthreads();
}

typedef __attribute__((address_space(1))) unsigned gu32;
#define XB_TMO      128
#define XB_XCNT(j)  (256  + 64 * (j))
#define XB_XSUB(j)  (1280 + 64 * (j))
#define XB_XGEN(j)  (2304 + 64 * (j))
#define XB_TOP      3328
#define XB_TOPGEN   3392
#define XCD_BAR_WORDS 3456
#define XB_SPIN_CAP (1u << 18)

__device__ __forceinline__ unsigned xb_ld(unsigned* p)              { return __hip_atomic_load(p, __ATOMIC_RELAXED, __HIP_MEMORY_SCOPE_AGENT); }
__device__ __forceinline__ unsigned xb_add(unsigned* p, unsigned v) { return __hip_atomic_fetch_add(p, v, __ATOMIC_RELAXED, __HIP_MEMORY_SCOPE_AGENT); }
__device__ __forceinline__ unsigned xb_xcc_id() { return (unsigned)__builtin_amdgcn_s_getreg((3 << 11) | 20) & 0xFu; }
#define XB_SPIN(cond, bar) do { unsigned _sp = 0; while (cond) { __builtin_amdgcn_s_sleep(1); \
    if ((++_sp & 255u) == 0u) { if (xb_ld(&(bar)[XB_TMO])) break; if (_sp > XB_SPIN_CAP) { atomicAdd(&(bar)[XB_TMO], 1u); break; } } } } while (0)

struct XcdBarrier {
    unsigned* bar; unsigned x;
    volatile LAS unsigned* st;
};

__device__ __forceinline__ XcdBarrier xcd_barrier_post(unsigned* bar, volatile LAS unsigned* st) {
    XcdBarrier b; b.bar = bar; b.x = xb_xcc_id(); b.st = st;
    if (threadIdx.x == 0) (void)xb_add(&bar[XB_XCNT(b.x)], 1u);
    return b;
}
__device__ __forceinline__ void xcd_barrier_complete(unsigned* bar, unsigned x, unsigned& nloc, unsigned& nx) {
    const unsigned G = gridDim.x * gridDim.y * gridDim.z;
    unsigned sum, cnt, mine, sp = 0u;
    for (;;) {
        sum = 0u; cnt = 0u; mine = 0u;
#pragma unroll
        for (unsigned j = 0; j < 16; ++j) { const unsigned c = xb_ld(&bar[XB_XCNT(j)]); sum += c; cnt += (c > 0u) ? 1u : 0u; mine = (j == x) ? c : mine; }
        if (sum == G) break;
        __builtin_amdgcn_s_sleep(1);
        if ((++sp & 255u) == 0u) { if (xb_ld(&bar[XB_TMO])) break; if (sp > XB_SPIN_CAP) { atomicAdd(&bar[XB_TMO], 1u); break; } }
    }
    nloc = mine > 0u ? mine : 1u; nx = cnt > 0u ? cnt : 1u;
}

__device__ __forceinline__ void xcd_barrier(const XcdBarrier& b) {
    asm volatile("s_waitcnt vmcnt(0)" ::: "memory");
    __syncthreads();
    if (threadIdx.x == 0) {
        unsigned* bar = b.bar;
        __builtin_amdgcn_s_waitcnt(0);
        unsigned nloc = b.st[0], nx = b.st[1];
        if (nloc == 0u) { xcd_barrier_complete(bar, b.x, nloc, nx); b.st[0] = nloc; b.st[1] = nx; }
        const unsigned old = xb_add(&bar[XB_XSUB(b.x)], 1u);
        const unsigned gen = old / nloc;
        if (old + 1u == (gen + 1u) * nloc) {
            __builtin_amdgcn_fence(__ATOMIC_RELEASE, "agent");
            asm volatile("s_waitcnt vmcnt(0)" ::: "memory");
            const unsigned og = xb_add(&bar[XB_TOP], 1u);
            const unsigned tg = og / nx;
            if (og + 1u == (tg + 1u) * nx) xb_add(&bar[XB_TOPGEN], 1u);
            else XB_SPIN(xb_ld(&bar[XB_TOPGEN]) == tg, bar);
            __builtin_amdgcn_fence(__ATOMIC_ACQUIRE, "agent");
            xb_add(&bar[XB_XGEN(b.x)], 1u);
            asm volatile("s_waitcnt vmcnt(0)" ::: "memory");
        } else {
            XB_SPIN(xb_ld(&bar[XB_XGEN(b.x)]) == gen, bar);
            __builtin_amdgcn_fence(__ATOMIC_ACQUIRE, "agent");
            asm volatile("s_waitcnt vmcnt(0)" ::: "memory");
        }
    }
    __syncthreads();
}

#define ATT_UNITS(ABLV) \
            for (int uu = vcu; uu < 256 + 1536; uu += G) { \
                int seq, h, m0, Lk; bool mla; size_t kr0; \
                if (uu < 256) { const int s = uu; if ((s & 3) == 0) continue; const int pu = (s >> 2) * 3 + (s & 3) - 1; seq = pu / 12; const int hx = pu % 12; mla = hx >= 6; h = mla ? hx - 6 : hx; m0 = seq * 256; Lk = 256; kr0 = (size_t)m0; } \
                else { const int u = uu - 256; const int pass = u >> 8, c = u & 255, idx = (pass >> 1) * 256 + c; const int b = idx / 96; h = (idx % 96) >> 4; const int qb = idx & 15; \
                       seq = 16 + b; mla = (pass & 1) != 0; m0 = MP + b * 4096 + qb * 256; Lk = LKS; kr0 = (size_t)MP + (size_t)b * LKS; } \
                if (!mla) attn_unit<64, ABLV>(lds, QA + (size_t)m0 * 384 + h * 64, 384, KA + kr0 * 128 + (h / 3) * 64, 128, VTA + vtbase(seq, 128) + (size_t)(h / 3) * 64 * Lk, Lk, MIX + (size_t)m0 * 1024 + h * 64, tid); \
                else attn_unit<96, ABLV>(lds, QB + (size_t)m0 * 576 + h * 96, 576, KB + kr0 * 576 + h * 96, 576, VTB + vtbase(seq, 384) + (size_t)h * 64 * Lk, Lk, MIX + (size_t)m0 * 1024 + 384 + h * 64, tid); \
            }
__global__ void __launch_bounds__(512, 2) mega(Args a) {
    extern __shared__ __attribute__((aligned(16))) unsigned char lds_raw[];
    LAS unsigned char* lds = (LAS unsigned char*)lds_raw;
    cg::grid_group grid = cg::this_grid();
    const int G = gridDim.x, bx = blockIdx.x;
#define LAUNDER_TID int tid = threadIdx.x; asm volatile("" : "+v"(tid)); const int lane = tid & 63, w = __builtin_amdgcn_readfirstlane(tid >> 6); const int gw = vcu * 8 + w
    const int vcu = (G % 8 == 0) ? (bx % 8) * (G / 8) + bx / 8 : bx;
    const int ngw = G * 8;
    int ph = 0;
    volatile LAS unsigned* bar_st = (volatile LAS unsigned*)(lds + LDS_BYTES - 64);
    if (threadIdx.x < 2) bar_st[threadIdx.x] = 0u;
    __syncthreads();
    XcdBarrier xbar = xcd_barrier_post((unsigned*)(a.ws + WS_BAR), bar_st);
#ifndef PMASK
#define PMASK 0xFFFF
#endif
#define PH_ON (a.ph_lo <= ph && ph < a.ph_hi)
#define PM(b) ((PMASK >> (b)) & 1)
#ifndef REPMASK
#define REPMASK 0
#endif
#define REPS(b) (((REPMASK >> (b)) & 1) ? 2 : 1)
#define PH_END do { if (a.ph_lo <= ph && ph + 1 < a.ph_hi) { if (ph == 0) grid.sync(); else xcd_barrier(xbar); } ++ph; } while (0)
    float* X = a.out;
    bf16* H = (bf16*)(a.ws + WS_H);
    const float* MOD = (const float*)(a.ws + WS_MOD);

    if (PM(0) && PH_ON) for (int rep = 0; rep < REPS(0); ++rep) { LAUNDER_TID;
        p0_convert(a, lds, gw, ngw, w, lane);
        __syncthreads();
        for (int it = bx; it < 768; it += G) ada_partial_item(a, lds, it, tid);
    }
    PH_END;
    if (PM(1) && PH_ON) for (int rep = 0; rep < REPS(1); ++rep) { LAUNDER_TID;
        const float* P = (const float*)(a.ws + WS_MODP); float* Mo = (float*)(a.ws + WS_MOD);
        for (int i = bx * 512 + tid; i < NLAYER * 9 * 6144; i += G * 512) { const int l = i / (9 * 6144), r = i % (9 * 6144), n = r % 6144; float s = a.in[13][l * 6144 + n];
#pragma unroll
            for (int ks = 0; ks < 8; ++ks) s += P[(size_t)(l * 8 + ks) * 9 * 6144 + r];
            Mo[i] = s; }
    }
    PH_END;
    if (PM(2) && PH_ON) for (int rep = 0; rep < REPS(2); ++rep) { LAUNDER_TID; norm_rows(a.in[0], a.in[1], a.in[10], MOD, 0, 1024, H, gw, ngw, lane); }
    PH_END;

#pragma unroll 1
    for (int l = 0; l < NLAYER; ++l) {
        const float* mod_l = MOD + (size_t)l * 9 * 6144;
        if (PM(3) && PH_ON) for (int rep = 0; rep < REPS(3); ++rep) {
            pg8::Gemm g{H, (const bf16*)(a.ws + WS_WIN) + (size_t)l * 1536 * 1024, MT, NINP, 1024}; pg8::StaticOrder S; S.init(MT, NINP, G, bx);
            pg8::EpiBf16<0> E{(bf16*)(a.ws + WS_PROJ), NINP, nullptr, 0, 0, 1.f};
            pg8::gemm_phase<pg8::EpiBf16<0>, pg8::StaticOrder, true, true>(lds, g, S, E);
        }
        PH_END;
        if (PM(4) && PH_ON) for (int rep = 0; rep < REPS(4); ++rep) { LAUNDER_TID;
            post_tables(lds, tid); __syncthreads();
#ifdef PABLX
            for (int it = vcu; it < 1152 + 128; it += G) post_item<PABLX>(a, lds, l, it, tid, lane, w);
#endif
            for (int it = vcu; it < 1152 + 128; it += G) post_item<0>(a, lds, l, it, tid, lane, w);
        }
        PH_END;
        if (PM(5) && PH_ON) for (int rep = 0; rep < REPS(5); ++rep) { LAUNDER_TID;
            const bf16* QA = (const bf16*)(a.ws + WS_QA); const bf16* QB = (const bf16*)(a.ws + WS_QB); const bf16* KA = (const bf16*)(a.ws + WS_KA); const bf16* KB = (const bf16*)(a.ws + WS_KB);
            const bf16* VTA = (const bf16*)(a.ws + WS_VTA); const bf16* VTB = (const bf16*)(a.ws + WS_VTB); bf16* MIX = (bf16*)(a.ws + WS_PROJ);
            ATT_UNITS(0)
            __syncthreads();
            for (int s = vcu; s < 256; s += G) {
                s5_task<true>(a, (LAS float*)(lds + w * 16896), (LAS float*)(lds + 135168), l, 16 + (s >> 5), (s & 31) >> 1, s & 1, lane, w);
                if (w < 2) { const int id = s * 2 + w; s5_task<false>(a, (LAS float*)(lds + w * 16896), (LAS float*)(lds + 135168), l, id >> 5, (id & 31) >> 1, id & 1, lane, w); }
            }
            __syncthreads();
#ifdef ABLX
            __syncthreads();
            ATT_UNITS(ABLX)
#endif
        }
        PH_END;
        if (PM(6) && PH_ON) for (int rep = 0; rep < REPS(6); ++rep) { LAUNDER_TID; for (int it = vcu; it < 1152; it += G) glu_item(a, lds, l, it, tid, lane, w); }
        PH_END;
        if (PM(7) && PH_ON) {
            pg8::Gemm g{(const bf16*)(a.ws + WS_PROJ), (const bf16*)(a.ws + WS_WOUT) + (size_t)l * 1024 * 1024, MT, 1024, 1024}; pg8::StaticOrder S; S.init(MT, 1024, G, bx);
            EpiRes E{l == 0 ? a.in[0] : X, l == 0 ? a.in[1] : X + (size_t)MP * 1024, X, mod_l + 2048};
            pg8::gemm_phase<EpiRes, pg8::StaticOrder, true, true>(lds, g, S, E);
        }
        PH_END;
        if (PM(8) && PH_ON) for (int rep = 0; rep < REPS(8); ++rep) { LAUNDER_TID; norm_rows(X, X + (size_t)MP * 1024, a.in[11] + l * 1024, mod_l, 3072, 4096, H, gw, ngw, lane); }
        PH_END;
        if (PM(9) && PH_ON) for (int rep = 0; rep < REPS(9); ++rep) {
            pg8::Gemm g{H, (const bf16*)(a.ws + WS_WF1) + (size_t)l * 5632 * 1024, MT, NF1, 1024}; pg8::StaticOrder S; S.init(MT, NF1, G, bx);
            EpiSwiglu E{(bf16*)(a.ws + WS_HDN)};
            pg8::gemm_phase<EpiSwiglu, pg8::StaticOrder, true, true>(lds, g, S, E);
        }
        PH_END;
        if (PM(10) && PH_ON) {
            pg8::Gemm g{(const bf16*)(a.ws + WS_HDN), (const bf16*)(a.ws + WS_WF2) + (size_t)l * 1024 * 2816, MT, 1024, DFF}; pg8::StaticOrder S; S.init(MT, 1024, G, bx);
            EpiRes E{X, X + (size_t)MP * 1024, X, mod_l + 5120};
            pg8::gemm_phase<EpiRes, pg8::StaticOrder, true, true>(lds, g, S, E);
        }
        PH_END;
        if (PM(11) && PH_ON) { LAUNDER_TID;
            if (l + 1 < NLAYER) norm_rows(X, X + (size_t)MP * 1024, a.in[10] + (l + 1) * 1024, mod_l + 9 * 6144, 0, 1024, H, gw, ngw, lane);
            else final_norm_rows(X, a.in[35], gw, ngw, lane);
        }
        PH_END;
    }
}

extern "C" void kernel_launch(void* const* d_in, const int* in_sizes, int n_in, void* d_out, int out_size, void* d_ws, size_t ws_size, hipStream_t stream) {
    static int grid = 0;
    if (grid == 0) {
        if (n_in != 36 || ws_size < WS_TOTAL) { fprintf(stderr, "kernel_launch: unexpected n_in %d / ws %zu (need %zu)\n", n_in, ws_size, (size_t)WS_TOTAL); grid = -1; return; }
        int dev = 0, cus = 0, per_cu = 0;
        hipGetDevice(&dev); hipDeviceGetAttribute(&cus, hipDeviceAttributeMultiprocessorCount, dev);
        if (hipFuncSetAttribute((const void*)mega, hipFuncAttributeMaxDynamicSharedMemorySize, LDS_BYTES) != hipSuccess) fprintf(stderr, "kernel_launch: hipFuncSetAttribute failed\n");
        if (hipOccupancyMaxActiveBlocksPerMultiprocessor(&per_cu, (const void*)mega, 512, LDS_BYTES) != hipSuccess || per_cu < 1) { fprintf(stderr, "kernel_launch: occupancy query says %d\n", per_cu); per_cu = 1; }
        (void)hipGetLastError();
        grid = cus;
    }
    if (grid < 0) return;
    Args a{};
    for (int i = 0; i < 36; ++i) a.in[i] = (const float*)d_in[i];
    a.out = (float*)d_out; a.ws = (unsigned char*)d_ws;
#if defined(MK_MULTI)
    for (int p = 0; p < NPHASE; ++p) { a.ph_lo = p; a.ph_hi = p + 1; hipLaunchKernelGGL(mega, dim3(grid), dim3(512), LDS_BYTES, stream, a); }
#else
    a.ph_lo = 0; a.ph_hi = NPHASE;
    if (hipMemsetAsync((char*)d_ws + WS_BAR, 0, 16384, stream) != hipSuccess) fprintf(stderr, "kernel_launch: memset failed\n");
    void* args[] = {&a};
    hipError_t e = hipLaunchCooperativeKernel((const void*)mega, dim3(grid), dim3(512), args, LDS_BYTES, stream);
    if (e != hipSuccess) fprintf(stderr, "kernel_launch: cooperative launch failed: %s (grid %d)\n", hipGetErrorString(e), grid);
#endif
}
```
